# Optimizing an MI355X kernel written in HIP

```python
import math
import jax
import jax.numpy as jnp
from jax import lax
import numpy as np

D_MODEL = 1024
BATCH = 2
SEQ = 16384
DEPTH = 2

GRID_W = 64
CTX_LEN = 256
BRANCH_W = D_MODEL // 2
N_BRANCHES = 4
SHORT_CONV = 3
EPS = 1e-6
MASK_NEG = -1e30
LB_FLOOR = 1e-30

SSD_INNER = BRANCH_W
SSD_HEAD_DIM = 64
SSD_HEADS = SSD_INNER // SSD_HEAD_DIM
SSD_GROUPS = 2
SSD_STATE = 64
SSD_CHUNK = 128
SSD_CONV_CH = SSD_INNER + 2 * SSD_GROUPS * SSD_STATE
DT_MIN = 1e-3
DT_MAX = 1e-1

HY_WIDTH = BRANCH_W
HY_ORDER = 2
HY_HIDDEN = 64
HY_BANDS = 8
HY_POS_DIM = 1 + 2 * HY_BANDS
HY_DECAY_TARGET = 1e-2
HY_SHORT_PCT = 0.3
HY_LONG_PCT = 1.5

ML_HEADS = 4
ML_HEAD_DIM = BRANCH_W // ML_HEADS
ML_WIDTH = BRANCH_W
ML_CHUNK = 128

HG_HEADS = 4
HG_EXPAND = BRANCH_W // HG_HEADS
HG_HEAD_DIM = BRANCH_W // HG_HEADS
HG_WIDTH = BRANCH_W
HG_CHUNK = 64
HG_SUB = 8

N_EXPERTS = 16
EC_CAPACITY = 2
D_EXPERT = 2 * D_MODEL

SSD_COLS = SSD_INNER + SSD_CONV_CH + 2 * SSD_HEADS
HY_COLS = (HY_ORDER + 1) * HY_WIDTH
ML_COLS = 4 * ML_WIDTH + 4 * ML_HEADS
HG_COLS = 5 * HG_WIDTH
GATE_COLS = N_BRANCHES * D_MODEL
PROJ_CUTS = (SSD_COLS, SSD_COLS + HY_COLS, SSD_COLS + HY_COLS + ML_COLS,
             SSD_COLS + HY_COLS + ML_COLS + HG_COLS)
PROJ_COLS = PROJ_CUTS[-1] + GATE_COLS

kernel_name = 'hybrid_bidir_ssd_hyena_mlstm_hgrn2_ecmoe'


def rmsnorm(x, g):
    xf = x.astype(jnp.float32)
    y = xf * lax.rsqrt(jnp.mean(xf * xf, axis=-1, keepdims=True) + EPS)
    return (y * g.astype(jnp.float32)).astype(x.dtype)


def head_rmsnorm(y, g):
    yf = y.astype(jnp.float32)
    yf = yf * lax.rsqrt(jnp.mean(yf * yf, axis=-1, keepdims=True) + EPS)
    return yf.reshape(y.shape[:2] + (-1,)) * g.astype(jnp.float32)


def modulate(h, shift, scale):
    return h * (1.0 + scale) + shift


def masked_exp(mask, logd):
    return jnp.where(mask, jnp.exp(jnp.where(mask, logd, 0.0)), 0.0)


def short_conv(u, w, bias):
    y = lax.conv_general_dilated(u, w[:, None, :].astype(u.dtype), window_strides=(1,), padding='SAME',
                                 dimension_numbers=('NWC', 'WIO', 'NWC'), feature_group_count=u.shape[-1])
    return y + bias.astype(u.dtype)


def to_col_major(t):
    b, n = t.shape[:2]
    rows = n // GRID_W
    rest = t.shape[2:]
    return t.reshape((b, rows, GRID_W) + rest).swapaxes(1, 2).reshape((b, n) + rest)


def to_row_major(t):
    b, n = t.shape[:2]
    rows = n // GRID_W
    rest = t.shape[2:]
    return t.reshape((b, GRID_W, rows) + rest).swapaxes(1, 2).reshape((b, n) + rest)


def bidirectional(scan_fn, ctx_fwd, ctx_bwd, lat_fwd, lat_bwd, init):
    flip = lambda ts: tuple(jnp.flip(t, axis=1) for t in ts)
    yc_f, sc_f = scan_fn(*ctx_fwd, init)
    yl_f, _ = scan_fn(*lat_fwd, sc_f)
    yc_b, sc_b = scan_fn(*flip(ctx_bwd), init)
    yl_b, _ = scan_fn(*flip(lat_bwd), sc_b)
    return yc_f + jnp.flip(yc_b, axis=1), yl_f + jnp.flip(yl_b, axis=1)


def ssd_scan(xs, dt, da, bm, cm, h0):
    b, n, H, P = xs.shape
    G = bm.shape[2]
    nc = n // SSD_CHUNK
    rep = H // G
    chunk = lambda t: t.reshape((b, nc, SSD_CHUNK) + t.shape[2:])
    xs, dt, da = chunk(xs), chunk(dt), chunk(da)
    bh = chunk(jnp.repeat(bm, rep, axis=2))
    ch = chunk(jnp.repeat(cm, rep, axis=2))
    acs = jnp.cumsum(da, axis=2)
    tri = jnp.tril(jnp.ones((SSD_CHUNK, SSD_CHUNK), bool))
    decay = masked_exp(tri[:, :, None], acs[:, :, :, None, :] - acs[:, :, None, :, :])
    scores = jnp.einsum('bcthn,bcshn->bctsh', ch, bh) * decay * dt[:, :, None, :, :]
    y_diag = jnp.einsum('bctsh,bcshp->bcthp', scores, xs)
    to_end = jnp.exp(acs[:, :, -1:, :] - acs) * dt
    states = jnp.einsum('bcsh,bcshn,bcshp->bchpn', to_end, bh, xs)
    chunk_decay = jnp.exp(acs[:, :, -1, :])

    def step(h, inp):
        dec, st = inp
        return dec[:, :, None, None] * h + st, h

    final, h_prev = lax.scan(step, h0, (chunk_decay.swapaxes(0, 1), states.swapaxes(0, 1)))
    h_prev = h_prev.swapaxes(0, 1)
    y_off = jnp.einsum('bcthn,bchpn->bcthp', ch, h_prev) * jnp.exp(acs)[..., None]
    return (y_diag + y_off).reshape(b, n, H, P), final


def ssd_inputs(p, conv_w, conv_b, dt_bias, a_log):
    b, n = p.shape[:2]
    z, xbc, dt = jnp.split(p, [SSD_INNER, SSD_INNER + SSD_CONV_CH], axis=-1)
    xbc = jax.nn.silu(short_conv(xbc, conv_w, conv_b))
    xs, bm, cm = jnp.split(xbc, [SSD_INNER, SSD_INNER + SSD_GROUPS * SSD_STATE], axis=-1)
    xs = xs.reshape(b, n, SSD_HEADS, SSD_HEAD_DIM)
    bm = bm.reshape(b, n, SSD_GROUPS, SSD_STATE)
    cm = cm.reshape(b, n, SSD_GROUPS, SSD_STATE)
    dt = jax.nn.softplus(dt.astype(jnp.float32).reshape(b, n, 2, SSD_HEADS) + dt_bias.astype(jnp.float32))
    da = dt * -jnp.exp(a_log.astype(jnp.float32))
    fwd = (xs, dt[:, :, 0], da[:, :, 0], bm, cm)
    bwd = (xs, dt[:, :, 1], da[:, :, 1], bm, cm)
    return z, xs, fwd, bwd


def ssd_branch(p_lat, p_ctx, conv_w, conv_b, dt_bias, a_log, d_skip, norm_g):
    lat = ssd_inputs(p_lat, conv_w, conv_b, dt_bias, a_log)
    ctx = ssd_inputs(p_ctx, conv_w, conv_b, dt_bias, a_log)
    h0 = jnp.zeros((p_lat.shape[0], SSD_HEADS, SSD_HEAD_DIM, SSD_STATE), jnp.float32)
    y_ctx, y_lat = bidirectional(ssd_scan, ctx[2], ctx[3], lat[2], lat[3], h0)

    def finish(y, inp):
        z, xs = inp[0], inp[1]
        y = (y + d_skip.astype(jnp.float32)[:, None] * xs).reshape(z.shape)
        return rmsnorm(y * jax.nn.silu(z.astype(jnp.float32)), norm_g)

    return finish(y_lat, lat), finish(y_ctx, ctx)


def hyena_filter_spectra(n, w1, b1, w2, b2, w3, freq):
    f32 = jnp.float32
    pos = jnp.arange(n, dtype=f32)
    t = pos / max(n - 1, 1)
    bands = jnp.arange(1, HY_BANDS + 1, dtype=f32)
    ang = (2.0 * math.pi / n) * pos[:, None] * bands[None, :]
    feats = jnp.concatenate([t[:, None], jnp.cos(ang), jnp.sin(ang)], axis=-1)
    hid = jnp.sin(freq[0] * (feats @ w1 + b1))
    hid = jnp.sin(freq[1] * (hid @ w2 + b2))
    h = (hid @ w3).reshape(n, HY_ORDER, 2, HY_WIDTH)
    deltas = jnp.abs(jnp.linspace(math.log(HY_DECAY_TARGET) / HY_LONG_PCT,
                                  math.log(HY_DECAY_TARGET) / HY_SHORT_PCT, HY_WIDTH, dtype=f32))
    h = h * jnp.exp(-t[:, None] * deltas[None, :])[:, None, None, :]
    two_sided = jnp.concatenate([h[:, :, 0], jnp.zeros((1, HY_ORDER, HY_WIDTH), f32),
                                 jnp.flip(h[1:, :, 1], axis=0)], axis=0)
    two_sided = two_sided / (jnp.sum(jnp.abs(two_sided), axis=0, keepdims=True) + EPS)
    return jnp.fft.rfft(two_sided, axis=0)


def fft_longconv(u, spec, skip):
    n = u.shape[1]
    uf = jnp.fft.rfft(u, n=2 * n, axis=1)
    y = jnp.fft.irfft(uf * spec, n=2 * n, axis=1)[:, :n]
    return y + u * skip


def hyena_branch(p, conv_w, conv_b, w1, b1, w2, b2, w3, freq, skip):
    f32 = jnp.float32
    u = short_conv(p, conv_w, conv_b).astype(f32)
    parts = jnp.split(u, HY_ORDER + 1, axis=-1)
    spec = hyena_filter_spectra(p.shape[1], w1.astype(f32), b1.astype(f32), w2.astype(f32),
                                b2.astype(f32), w3.astype(f32), freq.astype(f32))
    z = parts[0]
    for o in range(HY_ORDER):
        z = parts[o + 1] * fft_longconv(z, spec[:, o], skip[o].astype(f32))
    return z


def mlstm_scan(q, k, v, logi, logf, state):
    b, n, H, _ = q.shape
    nc = n // ML_CHUNK
    chunk = lambda t: t.reshape((b, nc, ML_CHUNK) + t.shape[2:])
    q, k, v, logi, logf = chunk(q), chunk(k), chunk(v), chunk(logi), chunk(logf)
    bcum = jnp.cumsum(logf, axis=2)
    btot = bcum[:, :, -1]
    a = btot[:, :, None] - bcum + logi
    m_loc = jnp.max(a, axis=2)
    w_loc = jnp.exp(a - m_loc[:, :, None])
    c_loc = jnp.einsum('bcsh,bcshv,bcshk->bchvk', w_loc, v, k)
    n_loc = jnp.einsum('bcsh,bcshk->bchk', w_loc, k)

    def step(carry, inp):
        c_st, n_st, m_st = carry
        g, cl, nl, ml = inp
        m_new = jnp.maximum(g + m_st, ml)
        a_old, a_new = jnp.exp(g + m_st - m_new), jnp.exp(ml - m_new)
        c_new = a_old[..., None, None] * c_st + a_new[..., None, None] * cl
        n_new = a_old[..., None] * n_st + a_new[..., None] * nl
        return (c_new, n_new, m_new), carry

    sw = lambda t: t.swapaxes(0, 1)
    final, (c_prev, n_prev, m_prev) = lax.scan(step, state, (sw(btot), sw(c_loc), sw(n_loc), sw(m_loc)))
    c_prev, n_prev, m_prev = sw(c_prev), sw(n_prev), sw(m_prev)
    tri = jnp.tril(jnp.ones((ML_CHUNK, ML_CHUNK), bool))[:, :, None]
    dmat = jnp.where(tri, bcum[:, :, :, None, :] - bcum[:, :, None, :, :] + logi[:, :, None, :, :],
                     MASK_NEG)
    inter = bcum + m_prev[:, :, None, :]
    m_t = jnp.maximum(inter, jnp.max(dmat, axis=3))
    w = masked_exp(tri, dmat - m_t[:, :, :, None, :]) * jnp.einsum('bcthk,bcshk->bctsh', q, k)
    w_int = jnp.exp(inter - m_t)
    num = jnp.einsum('bctsh,bcshv->bcthv', w, v) + w_int[..., None] * jnp.einsum('bcthk,bchvk->bcthv', q, c_prev)
    den = jnp.sum(w, axis=3) + w_int * jnp.einsum('bcthk,bchk->bcth', q, n_prev)
    h = num / jnp.maximum(jnp.abs(den), jnp.exp(-m_t))[..., None]
    return h.reshape(b, n, H, -1), final


def mlstm_inputs(p, conv_w, conv_b, i_bias, f_bias):
    b, n = p.shape[:2]
    qk, v, o, gates = jnp.split(p, [2 * ML_WIDTH, 3 * ML_WIDTH, 4 * ML_WIDTH], axis=-1)
    q, k = jnp.split(jax.nn.silu(short_conv(qk, conv_w, conv_b)), 2, axis=-1)
    heads = lambda t: t.reshape(b, n, ML_HEADS, ML_HEAD_DIM)
    q, k, v = heads(q), heads(k) * (ML_HEAD_DIM ** -0.5), heads(v)
    gates = gates.astype(jnp.float32).reshape(b, n, 4, ML_HEADS)
    logi = gates[:, :, :2] + i_bias.astype(jnp.float32)
    logf = jax.nn.log_sigmoid(gates[:, :, 2:] + f_bias.astype(jnp.float32))
    fwd = (q, k, v, logi[:, :, 0], logf[:, :, 0])
    bwd = (q, k, v, logi[:, :, 1], logf[:, :, 1])
    return o, fwd, bwd


def mlstm_branch(p_lat, p_ctx, conv_w, conv_b, i_bias, f_bias, norm_g):
    o_l, lat_f, lat_b = mlstm_inputs(p_lat, conv_w, conv_b, i_bias, f_bias)
    o_c, ctx_f, ctx_b = mlstm_inputs(p_ctx, conv_w, conv_b, i_bias, f_bias)
    b = p_lat.shape[0]
    s0 = (jnp.zeros((b, ML_HEADS, ML_HEAD_DIM, ML_HEAD_DIM), jnp.float32),
          jnp.zeros((b, ML_HEADS, ML_HEAD_DIM), jnp.float32),
          jnp.zeros((b, ML_HEADS), jnp.float32))
    h_c, h_l = bidirectional(mlstm_scan, ctx_f, ctx_b, lat_f, lat_b, s0)
    fin = lambda hh, o: jax.nn.sigmoid(o.astype(jnp.float32)) * head_rmsnorm(hh, norm_g)
    return fin(h_l, o_l), fin(h_c, o_c)


def hgrn2_scan(q, k, v, logf, s0):
    b, n, H, K = q.shape
    V = v.shape[-1]
    nc, ns = n // HG_CHUNK, HG_CHUNK // HG_SUB
    sub = lambda t: t.reshape((b, nc, ns, HG_SUB) + t.shape[2:])
    bq = jnp.cumsum(logf.reshape(b, nc, HG_CHUNK, H, K), axis=2)
    bs = bq.reshape(b, nc, ns, HG_SUB, H, K)
    qs, ks, vs = sub(q), sub(k), sub(v)
    end = bs[:, :, :, -1]
    start = jnp.concatenate([jnp.zeros_like(end[:, :, :1]), end[:, :, :-1]], axis=2)
    tri = jnp.tril(jnp.ones((HG_SUB, HG_SUB), bool))
    pair = masked_exp(tri[:, :, None, None], bs[:, :, :, :, None] - bs[:, :, :, None])
    att = jnp.einsum('bcjthk,bcjshk,bcjtshk->bcjtsh', qs, ks, pair)
    o = jnp.einsum('bcjtsh,bcjshv->bcjthv', att, vs)
    earlier = jnp.tril(jnp.ones((ns, ns), bool), -1)
    qx = qs * jnp.exp(bs - start[:, :, :, None])
    kx = ks[:, :, None] * masked_exp(earlier[:, :, None, None, None],
                                     start[:, :, :, None, None] - bs[:, :, None])
    att_x = jnp.einsum('bcithk,bcijshk->bcitjsh', qx, kx)
    o = (o + jnp.einsum('bcitjsh,bcjshv->bcithv', att_x, vs)).reshape(b, nc, HG_CHUNK, H, V)
    qc = q.reshape(b, nc, HG_CHUNK, H, K)
    kc = k.reshape(b, nc, HG_CHUNK, H, K)
    vc = v.reshape(b, nc, HG_CHUNK, H, V)
    btot = bq[:, :, -1]
    s_loc = jnp.einsum('bcshk,bcshv->bchkv', kc * jnp.exp(btot[:, :, None] - bq), vc)

    def step(s, inp):
        dec, sl = inp
        return dec[..., None] * s + sl, s

    final, s_prev = lax.scan(step, s0, (jnp.exp(btot).swapaxes(0, 1), s_loc.swapaxes(0, 1)))
    s_prev = s_prev.swapaxes(0, 1)
    o = o + jnp.einsum('bcthk,bchkv->bcthv', qc * jnp.exp(bq), s_prev)
    return o.reshape(b, n, H, V), final


def hgrn2_inputs(p, lb):
    b, n = p.shape[:2]
    q, i, f_fwd, f_bwd, g = jnp.split(p, 5, axis=-1)
    q = jax.nn.silu(q).reshape(b, n, HG_HEADS, HG_EXPAND)
    i = i.reshape(b, n, HG_HEADS, HG_HEAD_DIM)
    lb = lb.reshape(HG_HEADS, HG_EXPAND)
    log_lb, log_ub = jnp.log(jnp.maximum(lb, LB_FLOOR)), jnp.log1p(-lb)

    def direction(pre):
        pre = pre.astype(jnp.float32).reshape(b, n, HG_HEADS, HG_EXPAND)
        logf = jnp.logaddexp(log_lb, log_ub + jax.nn.log_sigmoid(pre))
        key = (1.0 - lb) * jax.nn.sigmoid(-pre)
        return (q, key, i, logf)

    return g, direction(f_fwd), direction(f_bwd)


def hgrn2_branch(p_lat, p_ctx, lb, norm_g):
    g_l, lat_f, lat_b = hgrn2_inputs(p_lat, lb)
    g_c, ctx_f, ctx_b = hgrn2_inputs(p_ctx, lb)
    lat_f = tuple(to_col_major(t) for t in lat_f)
    lat_b = tuple(to_col_major(t) for t in lat_b)
    s0 = jnp.zeros((p_lat.shape[0], HG_HEADS, HG_EXPAND, HG_HEAD_DIM), jnp.float32)
    o_c, o_l = bidirectional(hgrn2_scan, ctx_f, ctx_b, lat_f, lat_b, s0)
    o_l = to_row_major(o_l)
    fin = lambda o, g: head_rmsnorm(o, norm_g) * jax.nn.sigmoid(g.astype(jnp.float32))
    return fin(o_l, g_l), fin(o_c, g_c)


def merge_branches(ys, gate_pre, w_branch, w_out):
    b, n = gate_pre.shape[:2]
    gates = jax.nn.sigmoid(gate_pre.astype(jnp.float32)).reshape(b, n, N_BRANCHES, D_MODEL)
    merged = gates[:, :, 0] * (ys[0].astype(w_branch.dtype) @ w_branch[0])
    for i in range(1, N_BRANCHES):
        merged = merged + gates[:, :, i] * (ys[i].astype(w_branch.dtype) @ w_branch[i])
    return merged.astype(w_out.dtype) @ w_out


def token_mixer(h, hc, ctx_out, w_in, ssd_conv_w, ssd_conv_b, ssd_dt_bias, ssd_a_log, ssd_d, ssd_norm_g,
                hy_conv_w, hy_conv_b, hy_w1, hy_b1, hy_w2, hy_b2, hy_w3, hy_freq, hy_skip,
                ml_conv_w, ml_conv_b, ml_i_bias, ml_f_bias, ml_norm_g, hg_lb, hg_norm_g, w_branch, w_out):
    pa, pb, pc, pd, pg = jnp.split(h @ w_in, PROJ_CUTS, axis=-1)
    qa, qb, qc, qd, qg = jnp.split(hc @ w_in, PROJ_CUTS, axis=-1)
    ya, ya_c = ssd_branch(pa, qa, ssd_conv_w, ssd_conv_b, ssd_dt_bias, ssd_a_log, ssd_d, ssd_norm_g)
    yc, yc_c = mlstm_branch(pc, qc, ml_conv_w, ml_conv_b, ml_i_bias, ml_f_bias, ml_norm_g)
    yd, yd_c = hgrn2_branch(pd, qd, hg_lb, hg_norm_g)
    hyena = lambda p: hyena_branch(p, hy_conv_w, hy_conv_b, hy_w1, hy_b1, hy_w2, hy_b2, hy_w3, hy_freq, hy_skip)
    y = merge_branches((ya, hyena(pb), yc, yd), pg, w_branch, w_out)
    if not ctx_out:
        return y, None
    y_c = merge_branches((ya_c, hyena(qb), yc_c, yd_c), qg, w_branch, w_out)
    return y, y_c


def expert_choice_ffn(h, w_router, w_gate, w_up, w_down):
    b, n, d = h.shape
    cap = EC_CAPACITY * n // N_EXPERTS
    aff = jax.nn.softmax((h @ w_router).astype(jnp.float32), axis=-1)
    score, idx = lax.top_k(jnp.swapaxes(aff, 1, 2), cap)
    xg = jax.vmap(lambda hh, ii: hh[ii])(h, idx)
    hid = jax.nn.silu(jnp.einsum('becd,edf->becf', xg, w_gate)) * jnp.einsum('becd,edf->becf', xg, w_up)
    ye = jnp.einsum('becf,efd->becd', hid, w_down) * score[..., None].astype(h.dtype)
    return jax.vmap(lambda ii, yy: jnp.zeros((n, d), yy.dtype).at[ii].add(yy))(
        idx.reshape(b, -1), ye.reshape(b, -1, d))


def setup_inputs(seed: int = 0) -> dict:
    key = jax.random.key(seed)
    ks = iter(jax.random.split(key, 48))
    f32 = jnp.float32

    def nrm(shape, scale):
        return jax.random.normal(next(ks), shape, f32) * scale

    def gain(shape):
        return 1.0 + nrm(shape, 0.02)

    dt = jnp.exp(jax.random.uniform(next(ks), (DEPTH, 2, SSD_HEADS), f32, math.log(DT_MIN), math.log(DT_MAX)))
    a_init = jax.random.uniform(next(ks), (DEPTH, 2, SSD_HEADS), f32, 1.0, 16.0)
    return {
        'x': nrm((BATCH, SEQ, D_MODEL), 1.0),
        'c': nrm((BATCH, D_MODEL), 1.0),
        'ctx': nrm((BATCH, CTX_LEN, D_MODEL), 1.0),
        'c_ctx': nrm((D_MODEL,), 1.0),
        'w_ada': nrm((DEPTH, D_MODEL, 6 * D_MODEL), 0.5 * D_MODEL ** -0.5),
        'b_ada': nrm((DEPTH, 6 * D_MODEL), 0.01),
        'norm1_g': gain((DEPTH, D_MODEL)),
        'norm2_g': gain((DEPTH, D_MODEL)),
        'w_in': nrm((DEPTH, D_MODEL, PROJ_COLS), D_MODEL ** -0.5),
        'ssd_conv_w': nrm((DEPTH, SHORT_CONV, SSD_CONV_CH), SHORT_CONV ** -0.5),
        'ssd_conv_b': nrm((DEPTH, SSD_CONV_CH), 0.01),
        'ssd_dt_bias': dt + jnp.log(-jnp.expm1(-dt)),
        'ssd_a_log': jnp.log(a_init),
        'ssd_d': 1.0 + nrm((DEPTH, SSD_HEADS), 0.1),
        'ssd_norm_g': gain((DEPTH, SSD_INNER)),
        'hy_conv_w': nrm((DEPTH, SHORT_CONV, HY_COLS), SHORT_CONV ** -0.5),
        'hy_conv_b': nrm((DEPTH, HY_COLS), 0.01),
        'hy_w1': nrm((DEPTH, HY_POS_DIM, HY_HIDDEN), HY_POS_DIM ** -0.5),
        'hy_b1': nrm((DEPTH, HY_HIDDEN), 0.01),
        'hy_w2': nrm((DEPTH, HY_HIDDEN, HY_HIDDEN), HY_HIDDEN ** -0.5),
        'hy_b2': nrm((DEPTH, HY_HIDDEN), 0.01),
        'hy_w3': nrm((DEPTH, HY_HIDDEN, HY_ORDER * 2 * HY_WIDTH), HY_HIDDEN ** -0.5),
        'hy_freq': 1.0 + nrm((DEPTH, 2, HY_HIDDEN), 0.1),
        'hy_skip': nrm((DEPTH, HY_ORDER, HY_WIDTH), 0.5),
        'ml_conv_w': nrm((DEPTH, SHORT_CONV, 2 * ML_WIDTH), SHORT_CONV ** -0.5),
        'ml_conv_b': nrm((DEPTH, 2 * ML_WIDTH), 0.01),
        'ml_i_bias': nrm((DEPTH, 2, ML_HEADS), 0.1),
        'ml_f_bias': jnp.linspace(3.0, 6.0, ML_HEADS, dtype=f32) + nrm((DEPTH, 2, ML_HEADS), 0.1),
        'ml_norm_g': gain((DEPTH, ML_WIDTH)),
        'hg_lb_logits': nrm((DEPTH, HG_HEADS * HG_EXPAND), 0.1),
        'hg_norm_g': gain((DEPTH, HG_WIDTH)),
        'w_branch': nrm((DEPTH, N_BRANCHES, BRANCH_W, D_MODEL), BRANCH_W ** -0.5),
        'w_out': nrm((DEPTH, D_MODEL, D_MODEL), D_MODEL ** -0.5),
        'w_router': nrm((DEPTH, D_MODEL, N_EXPERTS), D_MODEL ** -0.5),
        'w_gate': nrm((DEPTH, N_EXPERTS, D_MODEL, D_EXPERT), D_MODEL ** -0.5),
        'w_up': nrm((DEPTH, N_EXPERTS, D_MODEL, D_EXPERT), D_MODEL ** -0.5),
        'w_down': nrm((DEPTH, N_EXPERTS, D_EXPERT, D_MODEL), D_EXPERT ** -0.5),
        'final_g': gain((D_MODEL,)),
    }


def reference(x, c, ctx, c_ctx, w_ada, b_ada, norm1_g, norm2_g, w_in,
              ssd_conv_w, ssd_conv_b, ssd_dt_bias, ssd_a_log, ssd_d, ssd_norm_g,
              hy_conv_w, hy_conv_b, hy_w1, hy_b1, hy_w2, hy_b2, hy_w3, hy_freq, hy_skip,
              ml_conv_w, ml_conv_b, ml_i_bias, ml_f_bias, ml_norm_g,
              hg_lb_logits, hg_norm_g, w_branch, w_out,
              w_router, w_gate, w_up, w_down, final_g):
    p_lb = jax.nn.softmax(hg_lb_logits.astype(jnp.float32), axis=0)
    lower_bounds = jnp.maximum(jnp.cumsum(p_lb, axis=0) - p_lb[0], 0.0)
    for l in range(DEPTH):
        ctx_out = l < DEPTH - 1
        mod = jax.nn.silu(c) @ w_ada[l] + b_ada[l]
        mod_c = jax.nn.silu(c_ctx) @ w_ada[l] + b_ada[l]
        sh1, sc1, g1, sh2, sc2, g2 = jnp.split(mod[:, None, :], 6, axis=-1)
        csh1, csc1, cg1, csh2, csc2, cg2 = jnp.split(mod_c, 6)
        h = modulate(rmsnorm(x, norm1_g[l]), sh1, sc1)
        hc = modulate(rmsnorm(ctx, norm1_g[l]), csh1, csc1)
        y, y_c = token_mixer(h, hc, ctx_out, w_in[l],
                             ssd_conv_w[l], ssd_conv_b[l], ssd_dt_bias[l], ssd_a_log[l], ssd_d[l], ssd_norm_g[l],
                             hy_conv_w[l], hy_conv_b[l], hy_w1[l], hy_b1[l], hy_w2[l], hy_b2[l], hy_w3[l],
                             hy_freq[l], hy_skip[l],
                             ml_conv_w[l], ml_conv_b[l], ml_i_bias[l], ml_f_bias[l], ml_norm_g[l],
                             lower_bounds[l], hg_norm_g[l], w_branch[l], w_out[l])
        x = x + g1 * y
        x = x + g2 * expert_choice_ffn(modulate(rmsnorm(x, norm2_g[l]), sh2, sc2),
                                       w_router[l], w_gate[l], w_up[l], w_down[l])
        if ctx_out:
            ctx = ctx + cg1 * y_c
            ctx = ctx + cg2 * expert_choice_ffn(modulate(rmsnorm(ctx, norm2_g[l]), csh2, csc2),
                                                w_router[l], w_gate[l], w_up[l], w_down[l])
    return rmsnorm(x, final_g)
```

```cpp
#ifndef CPU_EMU
#include <hip/hip_runtime.h>
#endif
#include <stdint.h>
#include <stddef.h>
#include <math.h>
#include <stdio.h>

#ifndef CFG_SEQ
#define CFG_SEQ 16384
#endif
#ifndef CFG_CTX
#define CFG_CTX 256
#endif
#ifndef MK_PER_PHASE
#define MK_PER_PHASE 0
#endif
namespace cfg {
constexpr int SEQ = CFG_SEQ, CTXL = CFG_CTX, NB = 2, D = 1024, DEPTH = 2;
constexpr int NLAT = NB * SEQ, NCTX = NB * CTXL, MROWS = NLAT + NCTX;
constexpr int MT = MROWS / 256, MT_LAT = NLAT / 256;
constexpr int SC = (CTXL >= 256 ? 256 : 128);
constexpr int LSEQ = CTXL + SEQ, NSC = LSEQ / SC;
constexpr int GRID_W = 64, GROWS = SEQ / GRID_W;
constexpr int BW = 512;
constexpr int NE = 16, DE = 2048;
constexpr int CAP_LAT = 2 * SEQ / NE, CAP_CTX = 2 * CTXL / NE;
constexpr int GP_LAT = (CAP_LAT + 255) / 256 * 256, GP_CTX = (CAP_CTX + 255) / 256 * 256;
constexpr int NPAIR_LAT = NB * NE * GP_LAT, NPAIR = NPAIR_LAT + NB * NE * GP_CTX;
constexpr int PC_SSD_Z = 0, PC_SSD_X = 512, PC_SSD_B = 1024, PC_SSD_C = 1152;
constexpr int PC_ML_Q = 1280, PC_ML_K = 1792, PC_ML_V = 2304, PC_ML_O = 2816;
constexpr int PC_HG_Q = 3328, PC_HG_I = 3840, PC_HG_FF = 4352, PC_HG_FB = 4864, PC_HG_G = 5376;
constexpr int PCOLS = 5888, PN1 = 6144;
constexpr int HYC = 1536;
constexpr int HY_LD = 3072;
constexpr int GB_LD = 1536;
constexpr int WIN_COLS = 11552;
constexpr int NTHREADS = 512;
constexpr int LDS_BYTES = 147456;
}
using namespace cfg;

#ifdef CPU_EMU
#define LAS
#define GAS
#define ASM_VMCNT0()
#define ASM_VMCNT4()
#define ASM_VMCNT6()
#define ASM_LGKM0()
#define ASM_LGKM8()
#define ASM_CLOBBER()
#define WAVE_LDS_SYNC() emu::wave_sync()
#else
#define LAS __attribute__((address_space(3)))
#define GAS __attribute__((address_space(1)))
#define ASM_VMCNT0() asm volatile("s_waitcnt vmcnt(0)" ::: "memory")
#define ASM_VMCNT4() asm volatile("s_waitcnt vmcnt(4)" ::: "memory")
#define ASM_VMCNT6() asm volatile("s_waitcnt vmcnt(6)" ::: "memory")
#define ASM_LGKM0() asm volatile("s_waitcnt lgkmcnt(0)" ::: "memory")
#define ASM_LGKM8() asm volatile("s_waitcnt lgkmcnt(8)" ::: "memory")
#define ASM_CLOBBER() asm volatile("" ::: "memory")
#define WAVE_LDS_SYNC() __builtin_amdgcn_wave_barrier()
#endif

typedef unsigned short bf16_t;
typedef short bf16x8 __attribute__((ext_vector_type(8)));
typedef float f32x4 __attribute__((ext_vector_type(4)));
typedef float f32x2 __attribute__((ext_vector_type(2)));
typedef unsigned u32x4 __attribute__((ext_vector_type(4)));
typedef unsigned u32x2 __attribute__((ext_vector_type(2)));
#define GLD(T, p) (*(const GAS T*)(p))
#define GST(T, p) (*(GAS T*)(p))

__device__ __forceinline__ unsigned f2bf_bits(float f) { unsigned u = __float_as_uint(f); u += 0x7FFFu + ((u >> 16) & 1u); return u >> 16; }
__device__ __forceinline__ float bf2f(unsigned short b) { return __uint_as_float(((unsigned)b) << 16); }
__device__ __forceinline__ unsigned cvt_pk_bf16(float lo, float hi) {
#ifdef CPU_EMU
    return f2bf_bits(lo) | (f2bf_bits(hi) << 16);
#else
    typedef __bf16 bf16v2_ __attribute__((ext_vector_type(2)));
    const f32x2 v = {lo, hi}; const bf16v2_ b = __builtin_convertvector(v, bf16v2_); return __builtin_bit_cast(unsigned, b);
#endif
}
__device__ __forceinline__ bf16_t f2bf1(float x) {
#ifdef CPU_EMU
    return (bf16_t)f2bf_bits(x);
#else
    const __bf16 b = (__bf16)x; return __builtin_bit_cast(unsigned short, b);
#endif
}
__device__ __forceinline__ float bflo(unsigned w) { return __uint_as_float(w << 16); }
__device__ __forceinline__ float bfhi(unsigned w) { return __uint_as_float(w & 0xFFFF0000u); }
__device__ __forceinline__ float sigmoidf_(float x) { return __builtin_amdgcn_rcpf(1.0f + __expf(-x)); }
__device__ __forceinline__ float siluf_(float x) { return x * __builtin_amdgcn_rcpf(1.0f + __expf(-x)); }
__device__ __forceinline__ float softplusf_(float x) { return fmaxf(x, 0.f) + __logf(1.0f + __expf(-fabsf(x))); }
__device__ __forceinline__ float logsigmoidf_(float x) { return -softplusf_(-x); }
__device__ __forceinline__ int lane_id() { return (int)__builtin_amdgcn_mbcnt_hi(~0u, __builtin_amdgcn_mbcnt_lo(~0u, 0u)); }
__device__ __forceinline__ float wave_sum(float v) {
#pragma unroll
    for (int m = 32; m >= 1; m >>= 1) v += __shfl_xor(v, m);
    return v;
}

namespace wsmap {
constexpr size_t al(size_t x) { return (x + 4095) & ~(size_t)4095; }
constexpr size_t CTL = 0;
constexpr size_t CTL_BYTES = 65536;
constexpr size_t MOD = CTL + CTL_BYTES;
constexpr size_t LB = al(MOD + (size_t)DEPTH * 3 * 6144 * 4);
constexpr size_t TWL = al(LB + DEPTH * 512 * 4);
constexpr size_t TWC = al(TWL + (size_t)SEQ * 8);
constexpr size_t HID = al(TWC + (size_t)CTXL * 8);
constexpr size_t G32 = al(HID + (size_t)DEPTH * LSEQ * 64 * 4);
constexpr size_t AFF = al(G32 + (size_t)MROWS * 32 * 4);
constexpr size_t SELI = al(AFF + (size_t)NB * NE * LSEQ * 4);
constexpr size_t SELS = al(SELI + (size_t)NPAIR * 4);
constexpr size_t SLOT = al(SELS + (size_t)NPAIR * 4);
constexpr size_t SSQ = al(SLOT + (size_t)MROWS * NE * 4);
constexpr size_t CTXC = al(SSQ + (size_t)MROWS * 8 * 4);
constexpr size_t WSCR = al(CTXC + (size_t)NCTX * D * 4);
constexpr size_t WSCR_H = 0, WSCR_H1 = ((size_t)SEQ + 8) * 8, WSCR_Z1 = 2 * WSCR_H1;
constexpr size_t WSCR_PER = al(WSCR_Z1 + (size_t)2 * SEQ * 2) > 262144 ? al(WSCR_Z1 + (size_t)2 * SEQ * 2) : 262144;
constexpr size_t WT_IN = al(WSCR + 256 * WSCR_PER);
constexpr size_t WT_HY = al(WT_IN + (size_t)PN1 * 1024 * 2);
constexpr size_t WT_GB = al(WT_HY + (size_t)HYC * 1024 * 2);
constexpr size_t WT_OUT = al(WT_GB + (size_t)4096 * GB_LD * 2);
constexpr size_t HYB = al(WT_OUT + (size_t)1024 * 1024 * 2);
constexpr size_t BIG = al(HYB + (size_t)MROWS * HY_LD * 2);
constexpr size_t P = BIG;
constexpr size_t HYT = al(P + (size_t)MROWS * PCOLS * 2);
constexpr size_t YBT = al(HYT + (size_t)HYC * MROWS * 2);
constexpr size_t ST_SSD = al(YBT + (size_t)512 * MROWS * 2);
constexpr size_t DEC_SSD = al(ST_SSD + (size_t)32 * NSC * 4096 * 4);
constexpr size_t ST_ML = al(DEC_SSD + (size_t)32 * NSC * 4);
constexpr size_t DEC_ML = al(ST_ML + (size_t)16 * NSC * 144 * 128 * 4);
constexpr size_t ST_HG = al(DEC_ML + (size_t)16 * NSC * 4);
constexpr size_t DEC_HG = al(ST_HG + (size_t)16 * NSC * 16384 * 4);
constexpr size_t MIX_END = al(DEC_HG + (size_t)16 * NSC * 128 * 4);
constexpr size_t T = P;
constexpr size_t XG = BIG;
constexpr size_t HIDB = al(XG + (size_t)NPAIR * 1024 * 2);
constexpr size_t WT_GU = al(HIDB + (size_t)NPAIR * 2048 * 2);
constexpr size_t WT_DN = al(WT_GU + (size_t)NE * 4096 * 1024 * 2);
constexpr size_t MOE_END = al(WT_DN + (size_t)NE * 1024 * 2048 * 2);
constexpr size_t END = MIX_END > MOE_END ? MIX_END : MOE_END;
}

struct Params {
    const float* in[38];
    float* out;
    unsigned char* ws;
    int ph_lo, ph_hi;
};
enum { I_X = 0, I_C, I_CTX, I_CCTX, I_WADA, I_BADA, I_N1G, I_N2G, I_WIN, I_SSD_CW, I_SSD_CB, I_SSD_DTB, I_SSD_ALOG, I_SSD_D, I_SSD_NG,
       I_HY_CW, I_HY_CB, I_HY_W1, I_HY_B1, I_HY_W2, I_HY_B2, I_HY_W3, I_HY_FREQ, I_HY_SKIP, I_ML_CW, I_ML_CB, I_ML_IB, I_ML_FB, I_ML_NG,
       I_HG_LB, I_HG_NG, I_WBR, I_WOUT, I_WROUTER, I_WGATE, I_WUP, I_WDOWN, I_FINALG };

#define XB_TMO      128
#define XB_XCNT(j)  (256  + 64 * (j))
#define XB_XSUB(j)  (1280 + 64 * (j))
#define XB_XGEN(j)  (2304 + 64 * (j))
#define XB_TOP      3328
#define XB_TOPGEN   3392
#define XCD_BAR_WORDS 3456
#define XB_SPIN_CAP (1u << 22)
__device__ __forceinline__ unsigned xb_ld(unsigned* p)              { return __hip_atomic_load(p, __ATOMIC_RELAXED, __HIP_MEMORY_SCOPE_AGENT); }
__device__ __forceinline__ unsigned xb_add(unsigned* p, unsigned v) { return __hip_atomic_fetch_add(p, v, __ATOMIC_RELAXED, __HIP_MEMORY_SCOPE_AGENT); }
__device__ __forceinline__ unsigned xb_xcc_id() { return (unsigned)__builtin_amdgcn_s_getreg((3 << 11) | 20) & 0xFu; }
#define XB_SPIN(cond, bar) do { unsigned _sp = 0; while (cond) { __builtin_amdgcn_s_sleep(1); \
    if ((++_sp & 255u) == 0u) { if (xb_ld(&(bar)[XB_TMO])) break; if (_sp > XB_SPIN_CAP) { atomicAdd(&(bar)[XB_TMO], 1u); break; } } } } while (0)
struct XcdBarrier { unsigned* bar; unsigned x; volatile LAS unsigned* st; };
__device__ __forceinline__ XcdBarrier xcd_barrier_post(unsigned* bar, volatile LAS unsigned* st, bool leader) {
    XcdBarrier b; b.bar = bar; b.x = xb_xcc_id(); b.st = st;
    if (leader) (void)xb_add(&bar[XB_XCNT(b.x)], 1u);
    return b;
}
__device__ __forceinline__ void xcd_barrier_complete(unsigned* bar, unsigned x, unsigned& nloc, unsigned& nx) {
    const unsigned G = gridDim.x * gridDim.y * gridDim.z;
    unsigned sum, cnt, mine, sp = 0u;
    for (;;) {
        sum = 0u; cnt = 0u; mine = 0u;
#pragma unroll
        for (unsigned j = 0; j < 16; ++j) { const unsigned c = xb_ld(&bar[XB_XCNT(j)]); sum += c; cnt += (c > 0u) ? 1u : 0u; mine = (j == x) ? c : mine; }
        if (sum == G) break;
        __builtin_amdgcn_s_sleep(1);
        if ((++sp & 255u) == 0u) { if (xb_ld(&bar[XB_TMO])) break; if (sp > XB_SPIN_CAP) { atomicAdd(&bar[XB_TMO], 1u); break; } }
    }
    nloc = mine > 0u ? mine : 1u; nx = cnt > 0u ? cnt : 1u;
}
__device__ __forceinline__ void xcd_barrier(const XcdBarrier& b, bool leader) {
    ASM_VMCNT0();
    __syncthreads();
    if (leader) {
        unsigned* bar = b.bar;
        __builtin_amdgcn_s_waitcnt(0);
        unsigned nloc = b.st[0], nx = b.st[1];
        if (nloc == 0u) { xcd_barrier_complete(bar, b.x, nloc, nx); b.st[0] = nloc; b.st[1] = nx; }
        const unsigned old = xb_add(&bar[XB_XSUB(b.x)], 1u);
        const unsigned gen = old / nloc;
        if (old + 1u == (gen + 1u) * nloc) {
            __builtin_amdgcn_fence(__ATOMIC_RELEASE, "agent");
            ASM_VMCNT0();
            const unsigned og = xb_add(&bar[XB_TOP], 1u);
            const unsigned tg = og / nx;
            if (og + 1u == (tg + 1u) * nx) xb_add(&bar[XB_TOPGEN], 1u);
            else XB_SPIN(xb_ld(&bar[XB_TOPGEN]) == tg, bar);
            __builtin_amdgcn_fence(__ATOMIC_ACQUIRE, "agent");
            xb_add(&bar[XB_XGEN(b.x)], 1u);
            ASM_VMCNT0();
        } else {
            XB_SPIN(xb_ld(&bar[XB_XGEN(b.x)]) == gen, bar);
            __builtin_amdgcn_fence(__ATOMIC_ACQUIRE, "agent");
            ASM_VMCNT0();
        }
    }
    __syncthreads();
}

namespace pg8 {
constexpr int BM = 256, BK = 64, HALF = 128, HTB = HALF * BK * 2, STAGE_BYTES = 8 * HTB;
__host__ __device__ __forceinline__ int lds_byte(int r, int c) { const int st = (r >> 4) * 2 + (c >> 5), rr = r & 15, cc = c & 31, ob = rr * 64 + cc * 2; return st * 1024 + (ob ^ (((ob >> 9) & 1) << 5)); }
__host__ __device__ __forceinline__ void stage_rc(int b, int& R, int& C) { const int st = b / 1024, sb = b % 1024, swz = sb ^ (((sb >> 9) & 1) << 5); R = (st >> 1) * 16 + swz / 64; C = (st & 1) * 32 + (swz % 64) / 2; }
__host__ __device__ __forceinline__ int perm32(int rho) { const int n = rho >> 4, i = rho & 15; return 8 * (i >> 2) + 4 * n + (i & 3); }
struct Unit { const char* A; const char* B; int nt; int a0, a1, a2; };
template <class Epi, class Sched>
__device__ __forceinline__ void gemm_phase(LAS unsigned char* lds, const int tid, const int lda, const int ldb, Sched& S, const Epi& E) {
    const int wid = __builtin_amdgcn_readfirstlane(tid >> 6), lane = tid & 63, wr = wid >> 2, wc = wid & 3, fr = lane & 15, fq = lane >> 4;
    unsigned voffA[2], voffB[2];
#pragma unroll
    for (int i = 0; i < 2; ++i) { int R, C; stage_rc(tid * 16 + i * 8192, R, C); const int Rb = Epi::PERM ? ((R & ~31) + perm32(R & 31)) : R;
        voffA[i] = (unsigned)(R * lda + C) * 2u; voffB[i] = (unsigned)(Rb * ldb + C) * 2u; }
    const size_t kstep = (size_t)(BK * 2);
    const size_t hstepA = (size_t)HALF * lda * 2, hstepB = (size_t)HALF * ldb * 2;
    const unsigned ldsw = (unsigned)wid * 1024u;
    const int aoff = lds_byte(wr * 64 + fr, fq * 8), boff = lds_byte(wc * 32 + fr, fq * 8);
#define PG8_SA(b, h) (((b) * 2 + (h)) * HTB)
#define PG8_SB(b, h) ((4 + (b) * 2 + (h)) * HTB)
#define PG8_STAGE(bufoff, gbase, voff) do { _Pragma("unroll") for (int _i = 0; _i < 2; ++_i) \
        __builtin_amdgcn_global_load_lds((const unsigned*)((const char*)(gbase) + (voff)[_i]), (LAS unsigned*)(lds + (bufoff) + ldsw + _i * 8192), 16, 0, 0); } while (0)
#define PG8_LDA(dst, b, h) do { _Pragma("unroll") for (int m = 0; m < 4; ++m) _Pragma("unroll") for (int k = 0; k < 2; ++k) dst[m][k] = *(const LAS bf16x8*)(lds + PG8_SA(b, h) + aoff + m * 2048 + k * 1024); } while (0)
#define PG8_LDB(dst, b, h) do { _Pragma("unroll") for (int n = 0; n < 2; ++n) _Pragma("unroll") for (int k = 0; k < 2; ++k) dst[n][k] = *(const LAS bf16x8*)(lds + PG8_SB(b, h) + boff + n * 2048 + k * 1024); } while (0)
#define PG8_MMA(ai, bj, At, Bt) do { __builtin_amdgcn_s_setprio(1); _Pragma("unroll") for (int m = 0; m < 4; ++m) _Pragma("unroll") for (int n = 0; n < 2; ++n) _Pragma("unroll") for (int k = 0; k < 2; ++k) \
        acc[ai][bj][m][n] = __builtin_amdgcn_mfma_f32_16x16x32_bf16(Bt[n][k], At[m][k], acc[ai][bj][m][n], 0, 0, 0); __builtin_amdgcn_s_setprio(0); } while (0)
#define PG8_BAR __builtin_amdgcn_s_barrier()
#define PG8_SCHED __builtin_amdgcn_sched_barrier(0)
    Unit cur, nxt; int ui = 0;
    if (!S.next(0, cur)) return;
    f32x4 acc[2][2][4][2];
#pragma unroll
    for (int a = 0; a < 2; ++a)
#pragma unroll
        for (int b = 0; b < 2; ++b)
#pragma unroll
            for (int m = 0; m < 4; ++m)
#pragma unroll
                for (int n = 0; n < 2; ++n) acc[a][b][m][n] = (f32x4){0.f, 0.f, 0.f, 0.f};
    bf16x8 At[4][2], B0[2][2], B1[2][2];
    const char* cA = cur.A; const char* cB = cur.B;
    PG8_STAGE(PG8_SB(0, 0), cB, voffB); PG8_STAGE(PG8_SA(0, 0), cA, voffA); PG8_STAGE(PG8_SB(0, 1), cB + hstepB, voffB); PG8_STAGE(PG8_SA(0, 1), cA + hstepA, voffA);
    if (wr == 1) PG8_BAR;
    ASM_VMCNT4(); PG8_BAR;
    PG8_STAGE(PG8_SB(1, 0), cB + kstep, voffB); PG8_STAGE(PG8_SA(1, 0), cA + kstep, voffA); PG8_STAGE(PG8_SB(1, 1), cB + hstepB + kstep, voffB);
    ASM_VMCNT6(); PG8_BAR;
    for (;;) {
        const bool has_next = S.next(ui + 1, nxt);
        const char* nA = has_next ? nxt.A : cA; const char* nB = has_next ? nxt.B : cB;
        const int nt = cur.nt;
        for (int t = 0; t < nt; t += 2) {
            const bool last = (t == nt - 2);
            const char* a1 = cA + (size_t)(t + 1) * kstep;
            const char* a2 = last ? nA : cA + (size_t)(t + 2) * kstep; const char* b2 = last ? nB : cB + (size_t)(t + 2) * kstep;
            const char* a3 = a2 + kstep; const char* b3 = b2 + kstep;
            PG8_LDB(B0, 0, 0); PG8_SCHED; PG8_LDA(At, 0, 0); PG8_STAGE(PG8_SA(1, 1), a1 + hstepA, voffA);
            ASM_LGKM8(); PG8_BAR; ASM_LGKM0(); PG8_MMA(0, 0, At, B0); PG8_BAR; PG8_SCHED;
            PG8_LDB(B1, 0, 1); PG8_STAGE(PG8_SB(0, 0), b2, voffB);
            PG8_BAR; ASM_LGKM0(); PG8_MMA(0, 1, At, B1); PG8_BAR;
            PG8_LDA(At, 0, 1); PG8_STAGE(PG8_SA(0, 0), a2, voffA);
            PG8_BAR; ASM_LGKM0(); PG8_MMA(1, 0, At, B0); PG8_BAR; PG8_SCHED;
            PG8_STAGE(PG8_SB(0, 1), b2 + hstepB, voffB);
            ASM_VMCNT6(); PG8_BAR; PG8_MMA(1, 1, At, B1); PG8_BAR;
            PG8_LDB(B0, 1, 0); PG8_SCHED; PG8_LDA(At, 1, 0); PG8_STAGE(PG8_SA(0, 1), a2 + hstepA, voffA);
            ASM_LGKM8(); PG8_BAR; ASM_LGKM0(); PG8_MMA(0, 0, At, B0); PG8_BAR; PG8_SCHED;
            PG8_LDB(B1, 1, 1); PG8_STAGE(PG8_SB(1, 0), b3, voffB);
            PG8_BAR; ASM_LGKM0(); PG8_MMA(0, 1, At, B1); PG8_BAR;
            PG8_LDA(At, 1, 1); PG8_STAGE(PG8_SA(1, 0), a3, voffA);
            PG8_BAR; ASM_LGKM0(); PG8_MMA(1, 0, At, B0); PG8_BAR; PG8_SCHED;
            PG8_STAGE(PG8_SB(1, 1), b3 + hstepB, voffB);
            ASM_VMCNT6(); PG8_BAR; PG8_MMA(1, 1, At, B1); PG8_BAR;
        }
        { int efr = fr, efq = fq;
#ifndef CPU_EMU
          asm volatile("" : "+v"(efr), "+v"(efq));
#endif
          E(acc, cur, wr, wc, efr, efq); }
        if (!has_next) break;
#pragma unroll
        for (int a = 0; a < 2; ++a)
#pragma unroll
            for (int b = 0; b < 2; ++b)
#pragma unroll
                for (int m = 0; m < 4; ++m)
#pragma unroll
                    for (int n = 0; n < 2; ++n) acc[a][b][m][n] = (f32x4){0.f, 0.f, 0.f, 0.f};
        cur = nxt; cA = nA; cB = nB; ++ui;
    }
    ASM_VMCNT0();
    if (wr == 0) PG8_BAR;
    PG8_BAR;
#undef PG8_SA
#undef PG8_SB
#undef PG8_STAGE
#undef PG8_LDA
#undef PG8_LDB
#undef PG8_MMA
#undef PG8_BAR
#undef PG8_SCHED
}
}

struct Frame {
    LAS unsigned char* lds;
    int tid, lane, wave, G, bid;
    unsigned char* ws;
    const Params* p;
};
#define WSP(T, off) ((T*)(F.ws + (off)))
constexpr int PTR_OFF = LDS_BYTES - 16 - 40 * 8;
__device__ __forceinline__ const float* inp(const Frame& F, int i) {
    const unsigned long long v = *(const LAS unsigned long long*)(F.lds + PTR_OFF + i * 8);
    const unsigned lo = __builtin_amdgcn_readfirstlane((unsigned)v), hi = __builtin_amdgcn_readfirstlane((unsigned)(v >> 32));
    return (const float*)(const GAS float*)(((unsigned long long)hi << 32) | lo);
}

__device__ __forceinline__ int row_sample(int row) { return row < NLAT ? row / SEQ : (row - NLAT) / CTXL; }
__device__ __forceinline__ int row_modset(int row) { return row < NLAT ? row / SEQ : 2; }
__device__ __forceinline__ int scan_row(int b, int dir, int j, bool colmajor) {
    if (j < CTXL) { const int t = dir ? (CTXL - 1 - j) : j; return NLAT + b * CTXL + t; }
    int q = j - CTXL; if (dir) q = SEQ - 1 - q;
    const int t = colmajor ? ((q % GROWS) * GRID_W + q / GROWS) : q;
    return b * SEQ + t;
}
__device__ __forceinline__ int row_prev(int row) { if (row < NLAT) return (row % SEQ) == 0 ? -1 : row - 1; return ((row - NLAT) % CTXL) == 0 ? -1 : row - 1; }
__device__ __forceinline__ int row_next(int row) { if (row < NLAT) return (row % SEQ) == SEQ - 1 ? -1 : row + 1; return ((row - NLAT) % CTXL) == CTXL - 1 ? -1 : row + 1; }

template <int NT> __device__ __forceinline__ void tconv_block(const Frame& F, const float* src0, size_t src_ld, bf16_t* dst0, size_t dst_ld) {
    constexpr int KL = NT == 64 ? 64 : 16;
    const int n = F.lane % NT, kq = F.lane / NT, k0 = F.wave * 64 + kq * KL;
    float v[KL];
    if (src0) { const float* sp = src0 + (size_t)k0 * src_ld + n;
#pragma unroll
        for (int k = 0; k < KL; ++k) v[k] = sp[(size_t)k * src_ld]; }
    else {
#pragma unroll
        for (int k = 0; k < KL; ++k) v[k] = 0.f; }
    bf16_t* dp = dst0 + (size_t)n * dst_ld + k0;
#pragma unroll
    for (int k = 0; k < KL; k += 8) { u32x4 w; w.x = cvt_pk_bf16(v[k], v[k + 1]); w.y = cvt_pk_bf16(v[k + 2], v[k + 3]); w.z = cvt_pk_bf16(v[k + 4], v[k + 5]); w.w = cvt_pk_bf16(v[k + 6], v[k + 7]);
        GST(u32x4, dp + k) = w; }
}
__device__ __forceinline__ int win_srccol(int r) {
    if (r < 1280) return r;
    if (r < 3328) return 2832 + (r - 1280);
    if (r < 5888) return 4896 + (r - 3328);
    if (r < 5904) return 1280 + (r - 5888);
    if (r < 5920) return 4880 + (r - 5904);
    return -1;
}
constexpr int CONVA_WIN = (PN1 / 16) * 2, CONVA_HY = (HYC / 64) * 2, CONVA_GATE = (4096 / 64) * 2, CONVA_BR = (4096 / 64), CONVA_OUT = (1024 / 64) * 2;
constexpr int CONVA_ITEMS = CONVA_WIN + CONVA_HY + CONVA_GATE + CONVA_BR + CONVA_OUT;
__device__ __forceinline__ void conv_dense_item(const Frame& F, int l, int it) {
    const float* w_in = inp(F, I_WIN) + (size_t)l * D * WIN_COLS;
    if (it < CONVA_WIN) { const int rb = it >> 1, kb = it & 1; const int sc = win_srccol(rb * 16);
        tconv_block<16>(F, sc < 0 ? nullptr : w_in + (size_t)kb * 512 * WIN_COLS + sc, WIN_COLS, WSP(bf16_t, wsmap::WT_IN) + (size_t)rb * 16 * 1024 + kb * 512, 1024); return; }
    it -= CONVA_WIN;
    if (it < CONVA_HY) { const int rb = it >> 1, kb = it & 1;
        tconv_block<64>(F, w_in + (size_t)kb * 512 * WIN_COLS + 1296 + rb * 64, WIN_COLS, WSP(bf16_t, wsmap::WT_HY) + (size_t)rb * 64 * 1024 + kb * 512, 1024); return; }
    it -= CONVA_HY;
    if (it < CONVA_GATE) { const int rb = it >> 1, kb = it & 1;
        tconv_block<64>(F, w_in + (size_t)kb * 512 * WIN_COLS + 7456 + rb * 64, WIN_COLS, WSP(bf16_t, wsmap::WT_GB) + (size_t)rb * 64 * GB_LD + kb * 512, GB_LD); return; }
    it -= CONVA_GATE;
    if (it < CONVA_BR) { const int r0 = it * 64, br = r0 >> 10, n0 = r0 & 1023;
        const float* wb = inp(F, I_WBR) + ((size_t)l * 4 + br) * BW * D;
        tconv_block<64>(F, wb + n0, D, WSP(bf16_t, wsmap::WT_GB) + (size_t)r0 * GB_LD + 1024, GB_LD); return; }
    it -= CONVA_BR;
    { const int rb = it >> 1, kb = it & 1; const float* wo = inp(F, I_WOUT) + (size_t)l * D * D;
      tconv_block<64>(F, wo + (size_t)kb * 512 * D + rb * 64, D, WSP(bf16_t, wsmap::WT_OUT) + (size_t)rb * 64 * 1024 + kb * 512, 1024); }
}
constexpr int CONVM_GU = NE * (4096 / 64) * 2, CONVM_DN = NE * (1024 / 64) * 4, CONVM_ITEMS = CONVM_GU + CONVM_DN;
__device__ __forceinline__ void conv_moe_item(const Frame& F, int l, int it) {
    if (it < CONVM_GU) { const int e = it / 128, r = it % 128, rb = r >> 1, kb = r & 1; const int r0 = rb * 64, pn = r0 >> 8, h = (r0 >> 7) & 1, i0 = r0 & 127;
        const float* src = inp(F, h ? I_WUP : I_WGATE) + ((size_t)l * NE + e) * D * DE + (size_t)kb * 512 * DE + pn * 128 + i0;
        tconv_block<64>(F, src, DE, WSP(bf16_t, wsmap::WT_GU) + ((size_t)e * 4096 + r0) * 1024 + kb * 512, 1024); return; }
    it -= CONVM_GU;
    { const int e = it / 64, r = it % 64, rb = r >> 2, kb = r & 3;
      const float* src = inp(F, I_WDOWN) + ((size_t)l * NE + e) * DE * D + (size_t)kb * 512 * D + rb * 64;
      tconv_block<64>(F, src, D, WSP(bf16_t, wsmap::WT_DN) + ((size_t)e * 1024 + rb * 64) * 2048 + kb * 512, 2048); }
}

__device__ __forceinline__ float sin_rad(float x) { const float r = x * 0.15915494309189535f; return __builtin_amdgcn_sinf(r - floorf(r)); }
constexpr int A0_MOD = DEPTH * (6144 / 64);
constexpr int A0_HID = DEPTH * (LSEQ / 8);
constexpr int A0_MISC = 1 + (SEQ + CTXL + NTHREADS - 1) / NTHREADS;
constexpr int A0_ITEMS = A0_MOD + A0_HID + A0_MISC + CONVA_ITEMS;
__device__ __forceinline__ void phase_a0(const Frame& F) {
    for (int it = F.bid; it < A0_ITEMS; it += F.G) {
        if (it < A0_MOD) {
            const int l = it / 96, j = (it % 96) * 64 + (F.tid & 63), ds = F.tid >> 6;
            const float* wa = inp(F, I_WADA) + (size_t)l * D * 6144;
            float a0 = 0.f, a1 = 0.f, a2 = 0.f;
            LAS float* sv = (LAS float*)(F.lds + 8192);
            __syncthreads();
            for (int i = F.tid; i < 3 * D; i += NTHREADS) sv[i] = siluf_(i < 2 * D ? inp(F, I_C)[i] : inp(F, I_CCTX)[i - 2 * D]);
            __syncthreads();
#pragma unroll 16
            for (int d = ds * 128; d < ds * 128 + 128; ++d) { const float w = wa[(size_t)d * 6144 + j]; a0 += sv[d] * w; a1 += sv[D + d] * w; a2 += sv[2 * D + d] * w; }
            LAS float* red = (LAS float*)F.lds;
            __syncthreads();
            red[(ds * 3 + 0) * 64 + (F.tid & 63)] = a0; red[(ds * 3 + 1) * 64 + (F.tid & 63)] = a1; red[(ds * 3 + 2) * 64 + (F.tid & 63)] = a2;
            __syncthreads();
            if (F.tid < 192) { const int s = F.tid >> 6, jj = F.tid & 63; float a = 0.f;
                for (int q = 0; q < 8; ++q) a += red[(q * 3 + s) * 64 + jj];
                const int jg = (it % 96) * 64 + jj;
                WSP(float, wsmap::MOD)[((size_t)l * 3 + s) * 6144 + jg] = a + inp(F, I_BADA)[(size_t)l * 6144 + jg]; }
            continue; }
        int i2 = it - A0_MOD;
        if (i2 < A0_HID) {
            const int l = i2 / (LSEQ / 8), pg = i2 % (LSEQ / 8), pl = F.tid >> 6, j = F.tid & 63, gp = pg * 8 + pl;
            const int n = gp < SEQ ? SEQ : CTXL, pos = gp < SEQ ? gp : gp - SEQ;
            LAS float* h1 = (LAS float*)F.lds;
            const float* w1 = inp(F, I_HY_W1) + (size_t)l * 17 * 64; const float* w2 = inp(F, I_HY_W2) + (size_t)l * 64 * 64;
            const float f0 = inp(F, I_HY_FREQ)[(l * 2 + 0) * 64 + j], f1 = inp(F, I_HY_FREQ)[(l * 2 + 1) * 64 + j];
            float a = inp(F, I_HY_B1)[l * 64 + j] + ((float)pos / (float)(n > 1 ? n - 1 : 1)) * w1[j];
            static_assert((SEQ & (SEQ - 1)) == 0 && (CTXL & (CTXL - 1)) == 0, "filter lengths are powers of two");
            const float rn = 1.0f / (float)n;
#pragma unroll
            for (int bnd = 1; bnd <= 8; ++bnd) { const float fr = (float)((pos * bnd) & (n - 1)) * rn;
                a += __builtin_amdgcn_cosf(fr) * w1[bnd * 64 + j] + __builtin_amdgcn_sinf(fr) * w1[(8 + bnd) * 64 + j]; }
            __syncthreads();
            h1[pl * 64 + j] = sin_rad(f0 * a);
            __syncthreads();
            float a2 = inp(F, I_HY_B2)[l * 64 + j];
            for (int i = 0; i < 64; ++i) a2 += h1[pl * 64 + i] * w2[i * 64 + j];
            WSP(bf16_t, wsmap::HID)[((size_t)l * LSEQ + gp) * 64 + j] = f2bf1(sin_rad(f1 * a2));
            continue; }
        i2 -= A0_HID;
        if (i2 < A0_MISC) {
            if (i2 == 0) {
                const int c = F.tid;
                float mx = -1e30f; for (int l = 0; l < DEPTH; ++l) mx = fmaxf(mx, inp(F, I_HG_LB)[l * 512 + c]);
                float den = 0.f; for (int l = 0; l < DEPTH; ++l) den += __expf(inp(F, I_HG_LB)[l * 512 + c] - mx);
                const float p0 = __expf(inp(F, I_HG_LB)[c] - mx) / den; float cum = 0.f;
                for (int l = 0; l < DEPTH; ++l) { cum += __expf(inp(F, I_HG_LB)[l * 512 + c] - mx) / den; WSP(float, wsmap::LB)[l * 512 + c] = fmaxf(cum - p0, 0.f); }
            } else { const int k = (i2 - 1) * NTHREADS + F.tid;
                if (k < SEQ) { float s, c; sincospif((float)k / (float)SEQ, &s, &c); WSP(f32x2, wsmap::TWL)[k] = (f32x2){c, -s}; }
                else if (k < SEQ + CTXL) { const int kk = k - SEQ; float s, c; sincospif((float)kk / (float)CTXL, &s, &c); WSP(f32x2, wsmap::TWC)[kk] = (f32x2){c, -s}; } }
            continue; }
        i2 -= A0_MISC;
        conv_dense_item(F, 0, i2);
    }
}

__device__ __forceinline__ void load_row16(const float* p, int lane, f32x4 (&v)[4]) {
#pragma unroll
    for (int i = 0; i < 4; ++i) v[i] = GLD(f32x4, p + i * 256 + lane * 4);
}
__device__ __forceinline__ void moe_combine_row(const Frame& F, int row, int lane, const float* g2, f32x4 (&v)[4]) {
    typedef int i32x4 __attribute__((ext_vector_type(4)));
    const int* slot = WSP(int, wsmap::SLOT) + (size_t)row * NE;
    i32x4 sl[4];
#pragma unroll
    for (int q = 0; q < 4; ++q) sl[q] = GLD(i32x4, slot + 4 * q);
    f32x4 acc[4];
#pragma unroll
    for (int i = 0; i < 4; ++i) acc[i] = (f32x4){0.f, 0.f, 0.f, 0.f};
#pragma unroll
    for (int e = 0; e < NE; ++e) { const int pr = sl[e >> 2][e & 3]; if (pr < 0) continue;
        const bf16_t* z = WSP(bf16_t, wsmap::XG) + (size_t)pr * 1024;
#pragma unroll
        for (int i = 0; i < 4; ++i) { const u32x2 w = GLD(u32x2, z + i * 256 + lane * 4);
            acc[i][0] += bflo(w.x); acc[i][1] += bfhi(w.x); acc[i][2] += bflo(w.y); acc[i][3] += bfhi(w.y); } }
#pragma unroll
    for (int i = 0; i < 4; ++i) { const f32x4 g = GLD(f32x4, g2 + i * 256 + lane * 4); v[i] += g * acc[i]; }
}
__device__ __forceinline__ void moe_combine_rows2(const Frame& F, int r0, int lane, const float* g2a, const float* g2b, f32x4 (&v)[2][4]) {
    typedef int i32x4 __attribute__((ext_vector_type(4)));
    i32x4 sl[2][4];
#pragma unroll
    for (int rr = 0; rr < 2; ++rr)
#pragma unroll
        for (int q = 0; q < 4; ++q) sl[rr][q] = GLD(i32x4, WSP(int, wsmap::SLOT) + (size_t)(r0 + rr) * NE + 4 * q);
    int pk[2][4], cnt[2];
#pragma unroll
    for (int rr = 0; rr < 2; ++rr) { int c = 0;
#pragma unroll
        for (int k = 0; k < 4; ++k) pk[rr][k] = -1;
#pragma unroll
        for (int e = 0; e < NE; ++e) { const int s = __builtin_amdgcn_readfirstlane(sl[rr][e >> 2][e & 3]); const bool val = s >= 0;
#pragma unroll
            for (int k = 0; k < 4; ++k) pk[rr][k] = (val && c == k) ? s : pk[rr][k];
            c += val ? 1 : 0; }
        cnt[rr] = c; }
    u32x2 w[2][4][4];
#pragma unroll
    for (int rr = 0; rr < 2; ++rr)
#pragma unroll
        for (int k = 0; k < 4; ++k) { const bf16_t* z = WSP(bf16_t, wsmap::XG) + (size_t)(pk[rr][k] < 0 ? 0 : pk[rr][k]) * 1024;
#pragma unroll
            for (int i = 0; i < 4; ++i) w[rr][k][i] = GLD(u32x2, z + i * 256 + lane * 4); }
#pragma unroll
    for (int rr = 0; rr < 2; ++rr) { f32x4 acc[4];
#pragma unroll
        for (int i = 0; i < 4; ++i) acc[i] = (f32x4){0.f, 0.f, 0.f, 0.f};
#pragma unroll
        for (int k = 0; k < 4; ++k) { if (pk[rr][k] < 0) continue;
#pragma unroll
            for (int i = 0; i < 4; ++i) { const u32x2 ww = w[rr][k][i]; acc[i][0] += bflo(ww.x); acc[i][1] += bfhi(ww.x); acc[i][2] += bflo(ww.y); acc[i][3] += bfhi(ww.y); } }
        if (cnt[rr] > 4) { int seen = 0;
#pragma unroll 1
            for (int e = 0; e < NE; ++e) { const int s = __builtin_amdgcn_readfirstlane(GLD(int, WSP(int, wsmap::SLOT) + (size_t)(r0 + rr) * NE + e)); if (s < 0) continue;
                if (seen >= 4) { const bf16_t* z = WSP(bf16_t, wsmap::XG) + (size_t)s * 1024;
#pragma unroll
                    for (int i = 0; i < 4; ++i) { const u32x2 ww = GLD(u32x2, z + i * 256 + lane * 4); acc[i][0] += bflo(ww.x); acc[i][1] += bfhi(ww.x); acc[i][2] += bflo(ww.y); acc[i][3] += bfhi(ww.y); } }
                ++seen; } }
        const float* g2 = rr ? g2b : g2a;
#pragma unroll
        for (int i = 0; i < 4; ++i) { const f32x4 g = GLD(f32x4, g2 + i * 256 + lane * 4); v[rr][i] += g * acc[i]; } }
}
__device__ __forceinline__ float* stream_row(const Frame& F, int row) { return row < NLAT ? (float*)(GAS float*)F.p->out + (size_t)row * D : WSP(float, wsmap::CTXC) + (size_t)(row - NLAT) * D; }
__device__ __forceinline__ const float* input_row(const Frame& F, int row) { return row < NLAT ? inp(F, I_X) + (size_t)row * D : inp(F, I_CTX) + (size_t)(row - NLAT) * D; }
__device__ __forceinline__ void norm_mod_store(const f32x4 (&v)[4], int lane, const float* g, const float* shift, const float* scale, bf16_t* dst, f32x4 (*hout)[4]) {
    float ss = 0.f;
#pragma unroll
    for (int i = 0; i < 4; ++i) ss += v[i][0] * v[i][0] + v[i][1] * v[i][1] + v[i][2] * v[i][2] + v[i][3] * v[i][3];
    ss = wave_sum(ss);
    const float rstd = __builtin_amdgcn_rsqf(ss * (1.0f / D) + 1e-6f);
#pragma unroll
    for (int i = 0; i < 4; ++i) { const int c = i * 256 + lane * 4;
        const f32x4 gg = GLD(f32x4, g + c), sh = GLD(f32x4, shift + c), sc = GLD(f32x4, scale + c);
        f32x4 h = v[i] * rstd * gg * (sc + 1.0f) + sh;
        if (hout) (*hout)[i] = h;
        u32x2 w; w.x = cvt_pk_bf16(h[0], h[1]); w.y = cvt_pk_bf16(h[2], h[3]);
        GST(u32x2, dst + c) = w; }
}
__device__ __forceinline__ void phase_norm1(const Frame& F, int l) {
    const int nrows = MROWS;
    for (int r0 = (F.bid * 8 + F.wave) * 2; r0 < nrows; r0 += F.G * 8 * 2) {
        f32x4 v[2][4];
#pragma unroll
        for (int rr = 0; rr < 2; ++rr) { const int row = r0 + rr;
            if (l == 0) load_row16(input_row(F, row), F.lane, v[rr]); else load_row16(stream_row(F, row), F.lane, v[rr]); }
        if (l > 0) moe_combine_rows2(F, r0, F.lane, WSP(float, wsmap::MOD) + ((size_t)(l - 1) * 3 + row_modset(r0)) * 6144 + 5 * 1024, WSP(float, wsmap::MOD) + ((size_t)(l - 1) * 3 + row_modset(r0 + 1)) * 6144 + 5 * 1024, v);
#pragma unroll
        for (int rr = 0; rr < 2; ++rr) { const int row = r0 + rr; const int ms = row_modset(row);
            if (l > 0) { float* xr = stream_row(F, row);
#pragma unroll
                for (int i = 0; i < 4; ++i) GST(f32x4, xr + i * 256 + F.lane * 4) = v[rr][i]; }
            const float* mod = WSP(float, wsmap::MOD) + ((size_t)l * 3 + ms) * 6144;
            norm_mod_store(v[rr], F.lane, inp(F, I_N1G) + (size_t)l * D, mod, mod + 1024, WSP(bf16_t, wsmap::HYB) + (size_t)row * HY_LD, nullptr); }
    }
}

constexpr int Q_WORD0 = 4096;
__device__ __forceinline__ int q_pull(const Frame& F, int q) {
    volatile LAS int* slot = (volatile LAS int*)(F.lds + LDS_BYTES - 32);
    __syncthreads();
    if (F.tid == 0) *slot = (int)__hip_atomic_fetch_add((unsigned*)(F.ws + wsmap::CTL) + Q_WORD0 + q * 64, 1u, __ATOMIC_RELAXED, __HIP_MEMORY_SCOPE_AGENT);
    __syncthreads();
    return *slot;
}
__device__ __forceinline__ void q_issue(const Frame& F, int q, int& nxt) {
    if (F.tid == 0) nxt = (int)__hip_atomic_fetch_add((unsigned*)(F.ws + wsmap::CTL) + Q_WORD0 + q * 64, 1u, __ATOMIC_RELAXED, __HIP_MEMORY_SCOPE_AGENT);
}
__device__ __forceinline__ int q_take(const Frame& F, int nxt) {
    volatile LAS int* slot = (volatile LAS int*)(F.lds + LDS_BYTES - 32);
    __syncthreads();
    if (F.tid == 0) *slot = nxt;
    __syncthreads();
    return *slot;
}
__device__ __forceinline__ void drain_moe_conv(const Frame& F, int l) {
    for (;;) { const int it = q_pull(F, l * 8 + 7); if (it >= CONVM_ITEMS) break; conv_moe_item(F, l, it); }
}
using pg8::Unit;
typedef f32x4 AccT[2][2][4][2];
__device__ __forceinline__ int xcd_vc(int bid, int G) { return (G & 7) == 0 ? (bid & 7) * (G >> 3) + (bid >> 3) : bid; }
struct SchedG1 { int G, c, nM, nN; const char* A; const char* B; size_t astep, bstep;
    __device__ __forceinline__ bool next(int i, Unit& u) const { const long L = (long)i * G + c; if (L >= (long)nM * nN) return false;
        const int pm = (int)(L / nN), pn = (int)(L % nN); u.A = A + (size_t)pm * astep; u.B = B + (size_t)pn * bstep; u.nt = 16; u.a0 = pm; u.a1 = pn; u.a2 = 0; return true; } };
struct EpiStoreBf16 { static constexpr bool PERM = true; bf16_t* O; size_t ld; float* G32; int small_pn;
    __device__ __forceinline__ void operator()(const AccT& acc, const Unit& u, int wr, int wc, int fr, int fq) const {
        const int row0 = u.a0 * 256 + wr * 64 + fr;
        if (u.a1 == small_pn) { if (wc == 0) {
#pragma unroll
            for (int ai = 0; ai < 2; ++ai)
#pragma unroll
                for (int m = 0; m < 4; ++m) { __builtin_amdgcn_sched_barrier(0); float* gp = G32 + (unsigned)((row0 + ai * 128 + m * 16) * 32 + 8 * fq);
                    GST(f32x4, gp) = acc[ai][0][m][0]; GST(f32x4, gp + 4) = acc[ai][0][m][1]; } }
            return; }
        const int col0 = u.a1 * 256 + wc * 32 + 8 * fq;
#pragma unroll
        for (int ai = 0; ai < 2; ++ai)
#pragma unroll
            for (int m = 0; m < 4; ++m) { __builtin_amdgcn_sched_barrier(0); bf16_t* rp = O + (unsigned)((row0 + ai * 128 + m * 16) * (int)ld + col0);
#pragma unroll
                for (int bj = 0; bj < 2; ++bj) { const f32x4 v0 = acc[ai][bj][m][0], v1 = acc[ai][bj][m][1];
                    u32x4 w; w.x = cvt_pk_bf16(v0[0], v0[1]); w.y = cvt_pk_bf16(v0[2], v0[3]); w.z = cvt_pk_bf16(v1[0], v1[1]); w.w = cvt_pk_bf16(v1[2], v1[3]);
                    GST(u32x4, rp + bj * 128) = w; } }
    } };
__device__ __forceinline__ void phase_proj(const Frame& F) {
    { SchedG1 S{F.G, F.bid, MT, PN1 / 256, (const char*)WSP(bf16_t, wsmap::HYB), (const char*)WSP(bf16_t, wsmap::WT_IN), (size_t)256 * HY_LD * 2, (size_t)256 * 1024 * 2};
      EpiStoreBf16 E{WSP(bf16_t, wsmap::P), (size_t)PCOLS, WSP(float, wsmap::G32), PN1 / 256 - 1};
      pg8::gemm_phase(F.lds, F.tid, HY_LD, 1024, S, E); }
    { const int extra = (MT * (PN1 / 256)) % F.G;
      SchedG1 S{F.G, (F.bid + F.G - extra) % F.G, HYC / 256, MT, (const char*)WSP(bf16_t, wsmap::WT_HY), (const char*)WSP(bf16_t, wsmap::HYB), (size_t)256 * 1024 * 2, (size_t)256 * HY_LD * 2};
      EpiStoreBf16 E{WSP(bf16_t, wsmap::HYT), (size_t)MROWS, nullptr, -1};
      pg8::gemm_phase(F.lds, F.tid, 1024, HY_LD, S, E); }
}
struct SchedGB { int G, c, nsu; const char* hyb; const char* wgb;
    __device__ __forceinline__ bool next(int i, Unit& u) const { const int s = i >> 3, sub = i & 7; const long L = (long)s * G + c; if (L >= nsu) return false;
        const int pm = (int)(L >> 2), j = (int)(L & 3), br = sub >> 1, kind = sub & 1;
        u.A = hyb + (size_t)pm * 256 * HY_LD * 2 + (kind ? 0 : (size_t)(1024 + br * 512) * 2);
        u.B = wgb + (size_t)(br * 1024 + j * 256) * GB_LD * 2 + (kind ? 0 : (size_t)1024 * 2);
        u.nt = kind ? 16 : 8; u.a0 = pm; u.a1 = j; u.a2 = sub; return true; } };
struct EpiGB { static constexpr bool PERM = true; bf16_t* PB; bf16_t* T; const float* ssq;
    __device__ __forceinline__ void operator()(const AccT& acc, const Unit& u, int wr, int wc, int fr, int fq) const {
        const int br = u.a2 >> 1, kind = u.a2 & 1, tid = (wr * 4 + wc) * 64 + fq * 16 + fr;
        const int row0 = u.a0 * 256 + wr * 64 + fr, col0 = u.a1 * 256 + wc * 32 + 8 * fq;
#pragma unroll
        for (int ai = 0; ai < 2; ++ai) { __builtin_amdgcn_sched_barrier(0);
            if (!kind) {
#pragma unroll
                for (int m = 0; m < 4; ++m)
#pragma unroll
                    for (int bj = 0; bj < 2; ++bj) { const f32x4 v0 = acc[ai][bj][m][0], v1 = acc[ai][bj][m][1];
                        u32x4 w; w.x = cvt_pk_bf16(v0[0], v0[1]); w.y = cvt_pk_bf16(v0[2], v0[3]); w.z = cvt_pk_bf16(v1[0], v1[1]); w.w = cvt_pk_bf16(v1[2], v1[3]);
                        GST(u32x4, PB + ((unsigned)tid * 8u + (unsigned)(((ai * 4 + m) * 2 + bj) * NTHREADS * 8))) = w; }
                continue; }
#pragma unroll
            for (int mh = 0; mh < 2; ++mh) { __builtin_amdgcn_sched_barrier(0);
                u32x4 pb[2][2], tt[2][2]; float rs[2];
#pragma unroll
                for (int mm = 0; mm < 2; ++mm) { const int m = mh * 2 + mm, row = row0 + ai * 128 + m * 16; rs[mm] = 1.0f;
#pragma unroll
                    for (int bj = 0; bj < 2; ++bj) { pb[mm][bj] = GLD(u32x4, PB + ((unsigned)tid * 8u + (unsigned)(((ai * 4 + m) * 2 + bj) * NTHREADS * 8)));
                        tt[mm][bj] = br ? GLD(u32x4, T + (unsigned)(row * 1024 + col0 + bj * 128)) : (u32x4){0u, 0u, 0u, 0u}; }
                    if (br == 0) { const f32x4 s0 = GLD(f32x4, ssq + (unsigned)(row * 8)), s1 = GLD(f32x4, ssq + (unsigned)(row * 8 + 4));
                        rs[mm] = __builtin_amdgcn_rsqf(((s0[0] + s0[1]) + (s0[2] + s0[3]) + (s1[0] + s1[1]) + (s1[2] + s1[3])) * (1.0f / 512.0f) + 1e-6f); } }
#pragma unroll
                for (int mm = 0; mm < 2; ++mm) { const int m = mh * 2 + mm, row = row0 + ai * 128 + m * 16;
#pragma unroll
                    for (int bj = 0; bj < 2; ++bj) { const f32x4 v0 = acc[ai][bj][m][0], v1 = acc[ai][bj][m][1]; const u32x4 p = pb[mm][bj], t = tt[mm][bj]; const float r = rs[mm];
                        float o[8];
                        o[0] = sigmoidf_(v0[0]) * bflo(p.x) * r + bflo(t.x); o[1] = sigmoidf_(v0[1]) * bfhi(p.x) * r + bfhi(t.x); o[2] = sigmoidf_(v0[2]) * bflo(p.y) * r + bflo(t.y); o[3] = sigmoidf_(v0[3]) * bfhi(p.y) * r + bfhi(t.y);
                        o[4] = sigmoidf_(v1[0]) * bflo(p.z) * r + bflo(t.z); o[5] = sigmoidf_(v1[1]) * bfhi(p.z) * r + bfhi(t.z); o[6] = sigmoidf_(v1[2]) * bflo(p.w) * r + bflo(t.w); o[7] = sigmoidf_(v1[3]) * bfhi(p.w) * r + bfhi(t.w);
                        u32x4 w; w.x = cvt_pk_bf16(o[0], o[1]); w.y = cvt_pk_bf16(o[2], o[3]); w.z = cvt_pk_bf16(o[4], o[5]); w.w = cvt_pk_bf16(o[6], o[7]);
                        GST(u32x4, T + (unsigned)(row * 1024 + col0 + bj * 128)) = w; } } } }
    } };
__device__ __forceinline__ void phase_gate_branch(const Frame& F, int l) {
    const int mt = (l < DEPTH - 1) ? MT : MT_LAT;
    SchedGB S{F.G, xcd_vc(F.bid, F.G), mt * 4, (const char*)WSP(bf16_t, wsmap::HYB), (const char*)WSP(bf16_t, wsmap::WT_GB)};
    EpiGB E{(bf16_t*)(F.ws + wsmap::WSCR + (size_t)F.bid * wsmap::WSCR_PER), WSP(bf16_t, wsmap::T), WSP(float, wsmap::SSQ)};
    pg8::gemm_phase(F.lds, F.tid, HY_LD, GB_LD, S, E);
    drain_moe_conv(F, l);
}
struct EpiOut { static constexpr bool PERM = false; const Frame* F; int l;
    __device__ __forceinline__ void operator()(const AccT& acc, const Unit& u, int wr, int wc, int fr, int fq) const {
        const int row0 = u.a0 * 256 + wr * 64 + fr, col0 = u.a1 * 256 + wc * 32 + 4 * fq;
#pragma unroll
        for (int ai = 0; ai < 2; ++ai)
#pragma unroll
            for (int mh = 0; mh < 2; ++mh) { __builtin_amdgcn_sched_barrier(0);
                f32x4 xs[2][2][2], gs[2][2][2];
#pragma unroll
                for (int mm = 0; mm < 2; ++mm) { const int row = row0 + ai * 128 + (mh * 2 + mm) * 16;
                    const float* g1 = (const float*)(F->ws + wsmap::MOD) + ((size_t)l * 3 + row_modset(row)) * 6144 + 2 * 1024;
                    const float* src = (l == 0) ? input_row(*F, row) : stream_row(*F, row);
#pragma unroll
                    for (int bj = 0; bj < 2; ++bj)
#pragma unroll
                        for (int n = 0; n < 2; ++n) { const int c = col0 + bj * 128 + n * 16; xs[mm][bj][n] = GLD(f32x4, src + c); gs[mm][bj][n] = GLD(f32x4, g1 + c); } }
#pragma unroll
                for (int mm = 0; mm < 2; ++mm) { const int m = mh * 2 + mm; float* dst = stream_row(*F, row0 + ai * 128 + m * 16);
#pragma unroll
                    for (int bj = 0; bj < 2; ++bj)
#pragma unroll
                        for (int n = 0; n < 2; ++n) GST(f32x4, dst + col0 + bj * 128 + n * 16) = xs[mm][bj][n] + gs[mm][bj][n] * acc[ai][bj][m][n]; } }
    } };
__device__ __forceinline__ void phase_outproj(const Frame& F, int l) {
    const int mt = (l < DEPTH - 1) ? MT : MT_LAT;
    SchedG1 S{F.G, xcd_vc(F.bid, F.G), mt, 4, (const char*)WSP(bf16_t, wsmap::T), (const char*)WSP(bf16_t, wsmap::WT_OUT), (size_t)256 * 1024 * 2, (size_t)256 * 1024 * 2};
    EpiOut E{&F, l};
    pg8::gemm_phase(F.lds, F.tid, 1024, 1024, S, E);
}
constexpr int RT_LAT = NPAIR_LAT / 256, RT_ALL = NPAIR / 256;
__device__ __forceinline__ int rt_expert(int rt) { return rt < RT_LAT ? (rt / (GP_LAT / 256)) % NE : ((rt - RT_LAT) / (GP_CTX / 256)) % NE; }
struct SchedMoe { int G, c, nrt, nN, nt; const char* A; const char* B; size_t astep, bstep_e, bstep_n;
    __device__ __forceinline__ bool next(int i, Unit& u) const { const long L = (long)i * G + c; if (L >= (long)nrt * nN) return false;
        int rt, pn;
        if (nN == 16) { const int blk = (int)(L >> 5), w = (int)(L & 31); rt = (blk >> 1) * 4 + (w & 3); pn = (blk & 1) * 8 + (w >> 2); }
        else { rt = (int)(L / nN); pn = (int)(L % nN); }
        const int e = rt_expert(rt);
        u.A = A + (size_t)rt * astep; u.B = B + (size_t)e * bstep_e + (size_t)pn * bstep_n; u.nt = nt; u.a0 = rt; u.a1 = pn; u.a2 = e; return true; } };
struct EpiGU { static constexpr bool PERM = true; bf16_t* H;
    __device__ __forceinline__ void operator()(const AccT& acc, const Unit& u, int wr, int wc, int fr, int fq) const {
        const int row0 = u.a0 * 256 + wr * 64 + fr, col0 = u.a1 * 128 + wc * 32 + 8 * fq;
#pragma unroll
        for (int ai = 0; ai < 2; ++ai)
#pragma unroll
            for (int m = 0; m < 4; ++m) { __builtin_amdgcn_sched_barrier(0); const f32x4 g0 = acc[ai][0][m][0], g1 = acc[ai][0][m][1], u0 = acc[ai][1][m][0], u1 = acc[ai][1][m][1];
                u32x4 w; w.x = cvt_pk_bf16(siluf_(g0[0]) * u0[0], siluf_(g0[1]) * u0[1]); w.y = cvt_pk_bf16(siluf_(g0[2]) * u0[2], siluf_(g0[3]) * u0[3]);
                w.z = cvt_pk_bf16(siluf_(g1[0]) * u1[0], siluf_(g1[1]) * u1[1]); w.w = cvt_pk_bf16(siluf_(g1[2]) * u1[2], siluf_(g1[3]) * u1[3]);
                GST(u32x4, H + (unsigned)((row0 + ai * 128 + m * 16) * 2048 + col0)) = w; }
    } };
struct EpiDown { static constexpr bool PERM = true; bf16_t* Z; const float* score;
    __device__ __forceinline__ void operator()(const AccT& acc, const Unit& u, int wr, int wc, int fr, int fq) const {
        const int row0 = u.a0 * 256 + wr * 64 + fr, col0 = u.a1 * 256 + wc * 32 + 8 * fq;
        float scv[2][4];
#pragma unroll
        for (int ai = 0; ai < 2; ++ai)
#pragma unroll
            for (int m = 0; m < 4; ++m) scv[ai][m] = GLD(float, score + row0 + ai * 128 + m * 16);
#pragma unroll
        for (int ai = 0; ai < 2; ++ai)
#pragma unroll
            for (int m = 0; m < 4; ++m) { __builtin_amdgcn_sched_barrier(0); const int row = row0 + ai * 128 + m * 16; const float sc = scv[ai][m];
#pragma unroll
                for (int bj = 0; bj < 2; ++bj) { const f32x4 v0 = acc[ai][bj][m][0] * sc, v1 = acc[ai][bj][m][1] * sc;
                    u32x4 w; w.x = cvt_pk_bf16(v0[0], v0[1]); w.y = cvt_pk_bf16(v0[2], v0[3]); w.z = cvt_pk_bf16(v1[0], v1[1]); w.w = cvt_pk_bf16(v1[2], v1[3]);
                    GST(u32x4, Z + (unsigned)(row * 1024 + col0 + bj * 128)) = w; } }
    } };
__device__ __forceinline__ void phase_moe_up(const Frame& F, int l) {
    SchedMoe S{F.G, xcd_vc(F.bid, F.G), (l < DEPTH - 1) ? RT_ALL : RT_LAT, 16, 16, (const char*)WSP(bf16_t, wsmap::XG), (const char*)WSP(bf16_t, wsmap::WT_GU), (size_t)256 * 1024 * 2, (size_t)4096 * 1024 * 2, (size_t)256 * 1024 * 2};
    EpiGU E{WSP(bf16_t, wsmap::HIDB)};
    pg8::gemm_phase(F.lds, F.tid, 1024, 1024, S, E);
}
__device__ __forceinline__ void phase_moe_down(const Frame& F, int l) {
    SchedMoe S{F.G, xcd_vc(F.bid, F.G), (l < DEPTH - 1) ? RT_ALL : RT_LAT, 4, 32, (const char*)WSP(bf16_t, wsmap::HIDB), (const char*)WSP(bf16_t, wsmap::WT_DN), (size_t)256 * 2048 * 2, (size_t)1024 * 2048 * 2, (size_t)256 * 2048 * 2};
    EpiDown E{WSP(bf16_t, wsmap::XG), WSP(float, wsmap::SELS)};
    pg8::gemm_phase(F.lds, F.tid, 2048, 2048, S, E);
}

__device__ __forceinline__ void phase_norm2_router(const Frame& F, int l) {
    const int nrows = (l < DEPTH - 1) ? MROWS : NLAT;
    const float* wr = inp(F, I_WROUTER) + (size_t)l * D * NE;
    for (int r0 = (F.bid * 8 + F.wave) * 4; r0 < nrows; r0 += F.G * 8 * 4) {
        f32x4 h[4][4];
#pragma unroll
        for (int rr = 0; rr < 4; ++rr) { const int row = r0 + rr; f32x4 v[4];
            load_row16(stream_row(F, row), F.lane, v);
            const float* mod = WSP(float, wsmap::MOD) + ((size_t)l * 3 + row_modset(row)) * 6144;
            norm_mod_store(v, F.lane, inp(F, I_N2G) + (size_t)l * D, mod + 3 * 1024, mod + 4 * 1024, WSP(bf16_t, wsmap::HYB) + (size_t)row * HY_LD, &h[rr]); }
        float lg[64];
#pragma unroll
        for (int e = 0; e < 64; ++e) lg[e] = 0.f;
#pragma unroll
        for (int i = 0; i < 4; ++i)
#pragma unroll
            for (int j = 0; j < 4; ++j) { const float* wp = wr + (size_t)(i * 256 + F.lane * 4 + j) * NE;
#pragma unroll
                for (int q = 0; q < 4; ++q) { const f32x4 w = GLD(f32x4, wp + q * 4);
#pragma unroll
                    for (int rr = 0; rr < 4; ++rr) { const float hv = h[rr][i][j];
                        lg[rr * 16 + q * 4 + 0] += hv * w[0]; lg[rr * 16 + q * 4 + 1] += hv * w[1]; lg[rr * 16 + q * 4 + 2] += hv * w[2]; lg[rr * 16 + q * 4 + 3] += hv * w[3]; } } }
#pragma unroll
        for (int m = 32; m >= 1; m >>= 1) { const bool up = (F.lane & m) != 0;
#pragma unroll
            for (int i = 0; i < m; ++i) { const float keep = up ? lg[i + m] : lg[i], send = up ? lg[i] : lg[i + m]; lg[i] = keep + __shfl_xor(send, m); } }
        const float logit = lg[0];
        float mx = logit;
#pragma unroll
        for (int m = 8; m >= 1; m >>= 1) mx = fmaxf(mx, __shfl_xor(mx, m));
        const float ex = __expf(logit - mx); float den = ex;
#pragma unroll
        for (int m = 8; m >= 1; m >>= 1) den += __shfl_xor(den, m);
        { const int row = r0 + (F.lane >> 4), e = F.lane & 15; float* aff = WSP(float, wsmap::AFF); const float a = ex * __builtin_amdgcn_rcpf(den);
          if (row < NLAT) GST(float, aff + ((size_t)(row / SEQ) * NE + e) * SEQ + (row % SEQ)) = a;
          else { const int r = row - NLAT; GST(float, aff + (size_t)NB * NE * SEQ + ((size_t)(r / CTXL) * NE + e) * CTXL + (r % CTXL)) = a; } }
    }
    drain_moe_conv(F, l);
}
template <int N> __device__ __forceinline__ void topk_set(const Frame& F, const float* aff, int cap, int pair_base, int gp, int srcrow_base, int e) {
    LAS unsigned* val = (LAS unsigned*)F.lds;
    LAS unsigned* hist = val + N;
    LAS unsigned* misc = hist + 256;
    __syncthreads();
    { static_assert(N % 4 == 0, "vector loads"); constexpr int NV = N / 4, U = 8;
#pragma unroll 1
      for (int i0 = F.tid; i0 < NV; i0 += U * NTHREADS) { u32x4 t[U];
#pragma unroll
          for (int u = 0; u < U; ++u) { const int idx = i0 + u * NTHREADS; t[u] = GLD(u32x4, (const unsigned*)aff + 4 * (idx < NV ? idx : i0)); }
#pragma unroll
          for (int u = 0; u < U; ++u) { const int idx = i0 + u * NTHREADS; if (idx < NV) *(LAS u32x4*)(val + 4 * idx) = t[u]; } } }
    if (F.tid == 0) { int capv = cap;
#ifndef CPU_EMU
        asm volatile("" : "+s"(capv));
#endif
        misc[0] = 0u; misc[1] = (unsigned)capv; }
    __syncthreads();
    for (int pass = 0; pass < 4; ++pass) {
        const int shift = 24 - 8 * pass;
        if (F.tid < 256) hist[F.tid] = 0u;
        __syncthreads();
        const unsigned prefix = misc[0], pmask = pass == 0 ? 0u : (0xFFFFFFFFu << (shift + 8));
        for (int i = F.tid; i < N; i += NTHREADS) { const unsigned v = val[i]; if ((v & pmask) == prefix) (void)__hip_atomic_fetch_add(&hist[(v >> shift) & 255u], 1u, __ATOMIC_RELAXED, __HIP_MEMORY_SCOPE_WORKGROUP); }
        __syncthreads();
        if (F.tid < 64) {
            const unsigned rem = misc[1]; const int L = F.lane;
            const unsigned h0 = hist[4 * L], h1 = hist[4 * L + 1], h2 = hist[4 * L + 2], h3 = hist[4 * L + 3];
            unsigned suf = h0 + h1 + h2 + h3;
#pragma unroll
            for (int d = 1; d < 64; d <<= 1) { const unsigned y = __shfl_down(suf, d); if (L + d < 64) suf += y; }
            unsigned above = suf - (h0 + h1 + h2 + h3);
            const unsigned hv[4] = {h3, h2, h1, h0};
#pragma unroll
            for (int q = 0; q < 4; ++q) { const unsigned c = hv[q];
                if (above < rem && rem <= above + c) { misc[0] = prefix | ((unsigned)(4 * L + 3 - q) << shift); misc[1] = rem - above; }
                above += c; } }
        __syncthreads();
    }
    const unsigned thr = misc[0], need_eq = misc[1];
    constexpr int PER = N / NTHREADS > 0 ? N / NTHREADS : 1;
    const int i0 = F.tid * PER;
    unsigned cg = 0, ce = 0;
    if (i0 < N) for (int i = i0; i < i0 + PER; ++i) { const unsigned v = val[i]; cg += v > thr; ce += v == thr; }
    LAS unsigned* sg = misc + 2; LAS unsigned* se = sg + NTHREADS;
    { unsigned ig = cg, ie = ce;
#pragma unroll
      for (int d = 1; d < 64; d <<= 1) { const unsigned yg = __shfl_up(ig, d), ye = __shfl_up(ie, d); if (F.lane >= d) { ig += yg; ie += ye; } }
      if (F.lane == 63) { sg[F.wave] = ig; se[F.wave] = ie; }
      __syncthreads();
      unsigned og = 0, oe = 0;
#pragma unroll
      for (int q = 0; q < 8; ++q) { if (q < F.wave) { og += sg[q]; oe += se[q]; } }
      __syncthreads();
      sg[F.tid] = og + ig - cg; se[F.tid] = oe + ie - ce; }
    __syncthreads();
    int* seli = WSP(int, wsmap::SELI); float* sels = WSP(float, wsmap::SELS); int* slot = WSP(int, wsmap::SLOT);
    if (i0 < N) { unsigned ng = sg[F.tid], neq = se[F.tid];
        for (int i = i0; i < i0 + PER; ++i) { const unsigned v = val[i]; int pr = -1;
            if (v > thr) { const unsigned eqsel = neq < need_eq ? neq : need_eq; pr = pair_base + (int)(ng + eqsel); ++ng; }
            else if (v == thr) { if (neq < need_eq) { pr = pair_base + (int)(ng + neq); } ++neq; }
            slot[(size_t)(srcrow_base + i) * NE + e] = pr;
            if (pr >= 0) { seli[pr] = srcrow_base + i; sels[pr] = __uint_as_float(v); } } }
    for (int i = cap + F.tid; i < gp; i += NTHREADS) { seli[pair_base + i] = -1; sels[pair_base + i] = 0.f; }
}
__device__ __forceinline__ void phase_topk(const Frame& F, int l) {
    const int nset = (l < DEPTH - 1) ? 2 * NB * NE : NB * NE;
    for (int it = F.bid; it < nset; it += F.G) {
        if (it < NB * NE) { const int b = it / NE, e = it % NE;
            topk_set<SEQ>(F, WSP(float, wsmap::AFF) + (size_t)it * SEQ, CAP_LAT, it * GP_LAT, GP_LAT, b * SEQ, e); }
        else { const int g = it - NB * NE, b = g / NE, e = g % NE;
            topk_set<CTXL>(F, WSP(float, wsmap::AFF) + (size_t)NB * NE * SEQ + (size_t)g * CTXL, CAP_CTX, NPAIR_LAT + g * GP_CTX, GP_CTX, NLAT + b * CTXL, e); }
    }
    if (l + 1 < DEPTH) for (;;) { const int it = q_pull(F, 32 + l); if (it >= CONVA_ITEMS) break; conv_dense_item(F, l + 1, it); }
}
__device__ __forceinline__ void phase_gather(const Frame& F, int l) {
    const int npr = (l < DEPTH - 1) ? NPAIR : NPAIR_LAT;
    const int* seli = WSP(int, wsmap::SELI);
    for (int pr0 = (F.bid * 8 + F.wave) * 4; pr0 < npr; pr0 += F.G * 8 * 4) {
        int srcs[4]; u32x4 a[4], b[4];
#pragma unroll
        for (int q = 0; q < 4; ++q) srcs[q] = GLD(int, seli + pr0 + q);
#pragma unroll
        for (int q = 0; q < 4; ++q) { a[q] = (u32x4){0u, 0u, 0u, 0u}; b[q] = a[q];
            if (srcs[q] >= 0) { const bf16_t* sp = WSP(bf16_t, wsmap::HYB) + (size_t)srcs[q] * HY_LD; a[q] = GLD(u32x4, sp + F.lane * 8); b[q] = GLD(u32x4, sp + 512 + F.lane * 8); } }
#pragma unroll
        for (int q = 0; q < 4; ++q) { bf16_t* dp = WSP(bf16_t, wsmap::XG) + (size_t)(pr0 + q) * 1024; GST(u32x4, dp + F.lane * 8) = a[q]; GST(u32x4, dp + 512 + F.lane * 8) = b[q]; }
    }
}
__device__ __forceinline__ void phase_final(const Frame& F) {
    for (int r0 = (F.bid * 8 + F.wave) * 2; r0 < NLAT; r0 += F.G * 8 * 2) {
        f32x4 v[2][4];
#pragma unroll
        for (int rr = 0; rr < 2; ++rr) { const int row = r0 + rr; const float* xr = (const float*)(GAS float*)F.p->out + (size_t)row * D;
            load_row16(xr, F.lane, v[rr]); }
        moe_combine_rows2(F, r0, F.lane, WSP(float, wsmap::MOD) + ((size_t)(DEPTH - 1) * 3 + row_modset(r0)) * 6144 + 5 * 1024, WSP(float, wsmap::MOD) + ((size_t)(DEPTH - 1) * 3 + row_modset(r0 + 1)) * 6144 + 5 * 1024, v);
#pragma unroll
        for (int rr = 0; rr < 2; ++rr) { float* xr = (float*)(GAS float*)F.p->out + (size_t)(r0 + rr) * D;
            float ss = 0.f;
#pragma unroll
            for (int i = 0; i < 4; ++i) ss += v[rr][i][0] * v[rr][i][0] + v[rr][i][1] * v[rr][i][1] + v[rr][i][2] * v[rr][i][2] + v[rr][i][3] * v[rr][i][3];
            ss = wave_sum(ss);
            const float rstd = __builtin_amdgcn_rsqf(ss * (1.0f / D) + 1e-6f);
#pragma unroll
            for (int i = 0; i < 4; ++i) { const int c = i * 256 + F.lane * 4; GST(f32x4, xr + c) = v[rr][i] * rstd * GLD(f32x4, inp(F, I_FINALG) + c); } }
    }
}

__device__ __forceinline__ f32x4 mma_nt(const LAS bf16_t* A, int lda, const LAS bf16_t* B, int ldb, int K, f32x4 acc, int lane, int ra = -1, int rb = -1) {
    const int gm = (K >> 3) - 1, kg = lane >> 4;
    const LAS bf16_t* ap = A + (lane & 15) * lda; const LAS bf16_t* bp = B + (lane & 15) * ldb;
#pragma unroll 2
    for (int kk = 0; kk < K; kk += 32) { const int g = (kk >> 3) + kg;
        const int oa = ra < 0 ? g * 8 : ((g + ra) & gm) * 8, ob = rb < 0 ? g * 8 : ((g + rb) & gm) * 8;
        acc = __builtin_amdgcn_mfma_f32_16x16x32_bf16(*(const LAS bf16x8*)(ap + oa), *(const LAS bf16x8*)(bp + ob), acc, 0, 0, 0); }
    return acc;
}
template <int G, int RS> __device__ __forceinline__ int tphys(int r, int t) { return ((((t >> 3) + (r >> RS)) & (G - 1)) << 3) | (t & 7); }
__device__ __forceinline__ void unpack8(const u32x4 w, float (&v)[8]) { v[0] = bflo(w.x); v[1] = bfhi(w.x); v[2] = bflo(w.y); v[3] = bfhi(w.y); v[4] = bflo(w.z); v[5] = bfhi(w.z); v[6] = bflo(w.w); v[7] = bfhi(w.w); }
__device__ __forceinline__ u32x4 ldp8(const bf16_t* P, int row, int col) { return row < 0 ? (u32x4){0u, 0u, 0u, 0u} : GLD(u32x4, P + (size_t)row * PCOLS + col); }
constexpr int NSC_C = CTXL / SC, NSC_L = SEQ / SC;
__device__ __forceinline__ int sc_mirror(int c) { return c < NSC_C ? (NSC_C - 1 - c) : NSC_C + (NSC_L - 1 - (c - NSC_C)); }
__device__ __forceinline__ void copy_g2l(const Frame& F, const bf16_t* g, LAS float* s, int n) {
#pragma unroll 4
    for (int i = F.tid * 8; i < n; i += NTHREADS * 8) { float v[8]; unpack8(GLD(u32x4, g + i), v);
        *(LAS f32x4*)(s + i) = (f32x4){v[0], v[1], v[2], v[3]}; *(LAS f32x4*)(s + i + 4) = (f32x4){v[4], v[5], v[6], v[7]}; }
}
__device__ __forceinline__ void copy_l2g(const Frame& F, const LAS float* s, bf16_t* g, int n) {
#pragma unroll 1
    for (int i = F.tid * 8; i < n; i += NTHREADS * 8) { const f32x4 a = *(const LAS f32x4*)(s + i), b = *(const LAS f32x4*)(s + i + 4);
        u32x4 w; w.x = cvt_pk_bf16(a[0], a[1]); w.y = cvt_pk_bf16(a[2], a[3]); w.z = cvt_pk_bf16(b[0], b[1]); w.w = cvt_pk_bf16(b[2], b[3]);
        GST(u32x4, g + i) = w; }
}
__device__ __forceinline__ float* wg_scratch(const Frame& F) { return (float*)(F.ws + wsmap::WSCR + (size_t)F.bid * wsmap::WSCR_PER); }

namespace hg { constexpr int T = 32, QF = 0, KF = 16896, BF = 33792, VT = 50688, KT = 60928, QD = 71168, ATT = 79872, ST = 82432, OB = 117248, BT = 134144, BSC = 134656, SEG = 135168, END = 137216; }
template <bool OUT> __device__ __forceinline__ void hg_pass(const Frame& F, int l, int b, int dir, int head, int scidx, f32x4 (&sacc)[8], bool second) {
    LAS unsigned char* L = F.lds; const int tid = F.tid, lane = F.lane, w = F.wave;
    LAS float* qf = (LAS float*)(L + hg::QF); LAS float* kf = (LAS float*)(L + hg::KF); LAS float* bfp = (LAS float*)(L + hg::BF);
    LAS bf16_t* vT = (LAS bf16_t*)(L + hg::VT); LAS bf16_t* kT = (LAS bf16_t*)(L + hg::KT); LAS bf16_t* qd = (LAS bf16_t*)(L + hg::QD);
    LAS bf16_t* att = (LAS bf16_t*)(L + hg::ATT); LAS bf16_t* STb = (LAS bf16_t*)(L + hg::ST); LAS float* ob = (LAS float*)(L + hg::OB);
    LAS float* btot = (LAS float*)(L + hg::BT); LAS float* bsc = (LAS float*)(L + hg::BSC);
    const bf16_t* P = WSP(bf16_t, wsmap::P); const float* lbp = WSP(float, wsmap::LB) + l * 512 + head * 128;
    float* oscr = wg_scratch(F);
    float lbv[8];
#pragma unroll
    for (int j = 0; j < 8; ++j) lbv[j] = GLD(float, lbp + (tid & 15) * 8 + j);
    u32x4 rq = (u32x4){0u, 0u, 0u, 0u}, rf, rv;
    { const bf16_t* pr = P + (size_t)scan_row(b, dir, scidx * SC + (tid >> 4), true) * PCOLS + head * 128 + (tid & 15) * 8;
      if (OUT) rq = GLD(u32x4, pr + PC_HG_Q);
      rf = GLD(u32x4, pr + (dir ? PC_HG_FB : PC_HG_FF)); rv = GLD(u32x4, pr + PC_HG_I); }
#pragma unroll 1
    for (int sub = 0; sub < SC / hg::T; ++sub) {
        const int j0 = scidx * SC + sub * hg::T;
        { const int t = tid >> 4, c8 = (tid & 15) * 8;
          float q[8], fp[8], vv[8];
          if (OUT) unpack8(rq, q);
          unpack8(rf, fp);
          const u32x4 vraw = rv;
          if (sub + 1 < SC / hg::T) { const bf16_t* pr = P + (size_t)scan_row(b, dir, j0 + hg::T + t, true) * PCOLS + head * 128 + c8;
              if (OUT) rq = GLD(u32x4, pr + PC_HG_Q);
              rf = GLD(u32x4, pr + (dir ? PC_HG_FB : PC_HG_FF)); rv = GLD(u32x4, pr + PC_HG_I); }
#pragma unroll
          for (int j = 0; j < 8; ++j) { const float lb = lbv[j], sg = sigmoidf_(fp[j]);
              if (OUT) qf[t * 132 + c8 + j] = siluf_(q[j]);
              kf[t * 132 + c8 + j] = (1.0f - lb) * (1.0f - sg);
              bfp[t * 132 + c8 + j] = __logf(fmaxf(lb, 1e-30f) + (1.0f - lb) * sg); }
          const unsigned vw[4] = {vraw.x, vraw.y, vraw.z, vraw.w};
#pragma unroll
          for (int j = 0; j < 8; ++j) vT[(c8 + j) * 40 + tphys<4, 3>(c8 + j, t)] = (bf16_t)((vw[j >> 1] >> ((j & 1) * 16)) & 0xFFFFu); }
        __syncthreads();
        u32x4 graw = (u32x4){0u, 0u, 0u, 0u}; f32x4 pk0 = (f32x4){0.f, 0.f, 0.f, 0.f}, pk1 = pk0;
        if (OUT && second) { const int t = tid >> 4, c8 = (tid & 15) * 8; const int jl = sub * hg::T + t, tl = dir ? (SC - 1 - jl) : jl;
            const float* sp = oscr + (size_t)tl * 128 + c8; pk0 = GLD(f32x4, sp); pk1 = GLD(f32x4, sp + 4);
            graw = GLD(u32x4, P + (size_t)scan_row(b, dir, j0 + t, true) * PCOLS + PC_HG_G + head * 128 + c8); }
        { LAS float* seg = (LAS float*)(L + hg::SEG); const int k = tid & 127, sg = tid >> 7;
          float v[8]; float run = 0.f;
#pragma unroll
          for (int i = 0; i < 8; ++i) { run += bfp[(sg * 8 + i) * 132 + k]; v[i] = run; }
          seg[sg * 128 + k] = run;
          __syncthreads();
          float off = 0.f;
#pragma unroll
          for (int s2 = 0; s2 < 3; ++s2) off += (s2 < sg) ? seg[s2 * 128 + k] : 0.f;
#pragma unroll
          for (int i = 0; i < 8; ++i) bfp[(sg * 8 + i) * 132 + k] = v[i] + off;
          if (sg == 3) { btot[k] = run + off; if (!OUT) bsc[k] += run + off; } }
        __syncthreads();
        { const int t = tid >> 4, c8 = (tid & 15) * 8;
          float qv[8];
#pragma unroll
          for (int j = 0; j < 8; ++j) { const int k = c8 + j; const float bb = bfp[t * 132 + k];
              qv[j] = OUT ? qf[t * 132 + k] * __expf(bb) : 0.f;
              kT[k * 40 + tphys<4, 3>(k, t)] = f2bf1(kf[t * 132 + k] * __expf(btot[k] - bb)); }
          if (OUT) { u32x4 w; w.x = cvt_pk_bf16(qv[0], qv[1]); w.y = cvt_pk_bf16(qv[2], qv[3]); w.z = cvt_pk_bf16(qv[4], qv[5]); w.w = cvt_pk_bf16(qv[6], qv[7]);
              *(LAS u32x4*)(qd + t * 136 + c8) = w; }
          }
        if (OUT) {
            LAS float* pt = ob;
#pragma unroll 1
            for (int u = w; u < 12; u += 8) { const int blk = u >> 2, ks = u & 3;
                const int t0 = blk == 0 ? 0 : 16, s0 = blk == 1 ? 16 : 0, rr = blk == 0 ? 7 : (blk == 1 ? 23 : 15);
                const int row = lane & 15, k0 = ks * 32 + (lane >> 4) * 8;
                bf16x8 af, bfr;
#pragma unroll
                for (int hh = 0; hh < 2; ++hh) { const int k = k0 + hh * 4;
                    const f32x4 rf = *(const LAS f32x4*)(bfp + rr * 132 + k);
                    const f32x4 qa = *(const LAS f32x4*)(qf + (t0 + row) * 132 + k), ba = *(const LAS f32x4*)(bfp + (t0 + row) * 132 + k);
                    const f32x4 kb2 = *(const LAS f32x4*)(kf + (s0 + row) * 132 + k), bb2 = *(const LAS f32x4*)(bfp + (s0 + row) * 132 + k);
#pragma unroll
                    for (int j = 0; j < 4; ++j) { af[hh * 4 + j] = (short)f2bf1(qa[j] * __expf(fminf(ba[j] - rf[j], 80.f))); bfr[hh * 4 + j] = (short)f2bf1(kb2[j] * __expf(fminf(rf[j] - bb2[j], 80.f))); } }
                const f32x4 pa = __builtin_amdgcn_mfma_f32_16x16x32_bf16(af, bfr, (f32x4){0.f, 0.f, 0.f, 0.f}, 0, 0, 0);
#pragma unroll
                for (int r = 0; r < 4; ++r) pt[u * 256 + ((lane >> 4) * 4 + r) * 16 + (lane & 15)] = pa[r]; }
            __syncthreads();
#pragma unroll
            for (int i2 = 0; i2 < 2; ++i2) { const int i = tid + i2 * NTHREADS, blk = i >> 8, e = i & 255, row = e >> 4, col = e & 15;
                if (blk < 3) { const int t = (blk == 0 ? 0 : 16) + row, s = (blk == 1 ? 16 : 0) + col;
                    const float a = (pt[(blk * 4 + 0) * 256 + e] + pt[(blk * 4 + 1) * 256 + e]) + (pt[(blk * 4 + 2) * 256 + e] + pt[(blk * 4 + 3) * 256 + e]);
                    att[t * 40 + s] = f2bf1(s <= t ? a : 0.f); }
                else att[row * 40 + 16 + col] = (bf16_t)0; } }
        __syncthreads();
        if (OUT) {
#pragma unroll
            for (int tt = 0; tt < 2; ++tt) { f32x4 a = (f32x4){0.f, 0.f, 0.f, 0.f};
                a = mma_nt(att + tt * 16 * 40, 40, vT + w * 16 * 40, 40, 32, a, lane, -1, (w * 16 + (lane & 15)) >> 3);
                a = mma_nt(qd + tt * 16 * 136, 136, STb + w * 16 * 136, 136, 128, a, lane);
#pragma unroll
                for (int r = 0; r < 4; ++r) ob[(tt * 16 + (lane >> 4) * 4 + r) * 132 + w * 16 + (lane & 15)] = a[r]; } }
#pragma unroll
        for (int kt = 0; kt < 8; ++kt) { __builtin_amdgcn_sched_barrier(0); const float e = __expf(btot[kt * 16 + (lane & 15)]);
            f32x4 a = sacc[kt] * e; a = mma_nt(vT + w * 16 * 40, 40, kT + kt * 16 * 40, 40, 32, a, lane, (w * 16 + (lane & 15)) >> 3, (kt * 16 + (lane & 15)) >> 3); sacc[kt] = a;
            if (OUT) {
#pragma unroll
                for (int r = 0; r < 4; ++r) STb[(w * 16 + (lane >> 4) * 4 + r) * 136 + kt * 16 + (lane & 15)] = f2bf1(a[r]); } }
        __syncthreads();
        if (OUT) { const int t = tid >> 4, c8 = (tid & 15) * 8; const int jl = sub * hg::T + t, tl = dir ? (SC - 1 - jl) : jl;
            float o[8];
#pragma unroll
            for (int j = 0; j < 8; ++j) o[j] = ob[t * 132 + c8 + j];
            float* sp = oscr + (size_t)tl * 128 + c8;
            if (!second) { GST(f32x4, sp) = (f32x4){o[0], o[1], o[2], o[3]}; GST(f32x4, sp + 4) = (f32x4){o[4], o[5], o[6], o[7]}; }
            else { const f32x4 p0 = pk0, p1 = pk1;
                o[0] += p0[0]; o[1] += p0[1]; o[2] += p0[2]; o[3] += p0[3]; o[4] += p1[0]; o[5] += p1[1]; o[6] += p1[2]; o[7] += p1[3];
                float ss = 0.f;
#pragma unroll
                for (int j = 0; j < 8; ++j) ss += o[j] * o[j];
                ss += __shfl_xor(ss, 1); ss += __shfl_xor(ss, 2); ss += __shfl_xor(ss, 4); ss += __shfl_xor(ss, 8);
                const float rstd = __builtin_amdgcn_rsqf(ss * (1.0f / 128.0f) + 1e-6f);
                const int row = scan_row(b, dir, j0 + t, true); float g[8];
                unpack8(graw, g);
                const float* ng = inp(F, I_HG_NG) + (size_t)l * 512 + head * 128 + c8;
#pragma unroll
                for (int j = 0; j < 8; ++j) o[j] = o[j] * rstd * ng[j] * sigmoidf_(g[j]);
                u32x4 wv; wv.x = cvt_pk_bf16(o[0], o[1]); wv.y = cvt_pk_bf16(o[2], o[3]); wv.z = cvt_pk_bf16(o[4], o[5]); wv.w = cvt_pk_bf16(o[6], o[7]);
                GST(u32x4, WSP(bf16_t, wsmap::HYB) + (size_t)row * HY_LD + 1024 + 3 * 512 + head * 128 + c8) = wv; } }
    }
}
__device__ __forceinline__ void hg_state_load(const Frame& F, const bf16_t* st, f32x4 (&sacc)[8]) {
    LAS float* stg = (LAS float*)F.lds; LAS bf16_t* STb = (LAS bf16_t*)(F.lds + hg::ST); const int lane = F.lane, w = F.wave;
    copy_g2l(F, st, stg, 16384);
    __syncthreads();
    const LAS float* sp = stg + (w * 16 + (lane >> 4) * 4) * 128 + (lane & 15); LAS bf16_t* bp = STb + (w * 16 + (lane >> 4) * 4) * 136 + (lane & 15);
#pragma unroll
    for (int kt = 0; kt < 8; ++kt)
#pragma unroll
        for (int r = 0; r < 4; ++r) { const float x = sp[r * 128 + kt * 16]; sacc[kt][r] = x; bp[r * 136 + kt * 16] = f2bf1(x); }
    __syncthreads();
}
__device__ __forceinline__ void hg_m1_item(const Frame& F, int l, int it) {
    const int chain = it / NSC, sc = it % NSC, head = chain & 3, dir = (chain >> 2) & 1, b = chain >> 3;
    f32x4 sacc[8];
#pragma unroll
    for (int kt = 0; kt < 8; ++kt) sacc[kt] = (f32x4){0.f, 0.f, 0.f, 0.f};
    LAS float* bsc = (LAS float*)(F.lds + hg::BSC);
    __syncthreads();
    if (F.tid < 128) bsc[F.tid] = 0.f;
    __syncthreads();
    hg_pass<false>(F, l, b, dir, head, sc, sacc, false);
    { LAS float* stg = (LAS float*)F.lds; LAS float* sp = stg + (F.wave * 16 + (F.lane >> 4) * 4) * 128 + (F.lane & 15);
#pragma unroll
      for (int kt = 0; kt < 8; ++kt)
#pragma unroll
          for (int r = 0; r < 4; ++r) sp[r * 128 + kt * 16] = sacc[kt][r];
      __syncthreads();
      copy_l2g(F, stg, WSP(bf16_t, wsmap::ST_HG) + (size_t)it * 16384, 16384); }
    if (F.tid < 128) WSP(float, wsmap::DEC_HG)[(size_t)it * 128 + F.tid] = __expf(bsc[F.tid]);
}
__device__ __forceinline__ void hg_m3_item(const Frame& F, int l, int it) {
    const int c = it % NSC, bh = it / NSC, head = bh & 3, b = bh >> 2;
    f32x4 sacc[8];
#pragma unroll
    for (int dir = 0; dir < 2; ++dir) { const int scidx = dir ? sc_mirror(c) : c; const int chain = (b * 2 + dir) * 4 + head;
        __syncthreads();
        hg_state_load(F, WSP(bf16_t, wsmap::ST_HG) + ((size_t)chain * NSC + scidx) * 16384, sacc);
        hg_pass<true>(F, l, b, dir, head, scidx, sacc, dir == 1); }
}

namespace ml { constexpr int T = 64, QB = 0, KB = 17408, VT = 34816, WKT = 55552, WM = 73984, CB = 83200, SCAL = 122368, CWL = 124416, END = 128512;
    constexpr int BC = 0, LI = 64, DN = 128, LF = 192; }
template <bool OUT> __device__ __forceinline__ void ml_pass(const Frame& F, int l, int b, int dir, int head, int scidx, f32x4 (&cacc)[9], float& dec_log, bool second) {
    LAS unsigned char* L = F.lds; const int tid = F.tid, lane = F.lane, w = F.wave;
    LAS bf16_t* qb = (LAS bf16_t*)(L + ml::QB); LAS bf16_t* kb = (LAS bf16_t*)(L + ml::KB); LAS bf16_t* vT = (LAS bf16_t*)(L + ml::VT);
    LAS bf16_t* wkT = (LAS bf16_t*)(L + ml::WKT); LAS bf16_t* Wm = (LAS bf16_t*)(L + ml::WM); LAS bf16_t* Cb = (LAS bf16_t*)(L + ml::CB);
    LAS float* sc = (LAS float*)(L + ml::SCAL); LAS float* ob = (LAS float*)(L + ml::QB);
    const bf16_t* P = WSP(bf16_t, wsmap::P); const float* G32 = WSP(float, wsmap::G32);
    const float* cw = inp(F, I_ML_CW) + (size_t)l * 3 * 1024; const float* cb = inp(F, I_ML_CB) + (size_t)l * 1024;
    const float ib = inp(F, I_ML_IB)[(l * 2 + dir) * 4 + head], fb = inp(F, I_ML_FB)[(l * 2 + dir) * 4 + head];
    float* oscr = wg_scratch(F);
    bf16_t* qkc = (bf16_t*)((unsigned char*)oscr + 131072);
    LAS float* cwl = (LAS float*)(L + ml::CWL);
    { const int j = tid >> 8, qc = tid & 255, ch = (qc >> 7) * 512 + head * 128 + (qc & 127);
      cwl[j * 256 + qc] = cw[j * 1024 + ch]; cwl[(j + 2) * 256 + qc] = j ? cb[ch] : cw[2048 + ch]; }
    __syncthreads();
    u32x4 rq[2][2], rh[2][2], rv[2]; float gi = 0.f, gf = 0.f;
#define ML_LOAD(J0) do { const int t_ = tid >> 3, c16_ = (tid & 7) * 16; const int row_ = scan_row(b, dir, (J0) + t_, false); \
        const int hrow_ = lane < 8 ? (dir ? row_next(row_) : row_prev(row_)) : (lane >= 56 ? (dir ? row_prev(row_) : row_next(row_)) : -1); \
        _Pragma("unroll") for (int hh_ = 0; hh_ < 2; ++hh_) { _Pragma("unroll") for (int qk_ = 0; qk_ < 2; ++qk_) { const int col_ = (qk_ ? PC_ML_K : PC_ML_Q) + head * 128 + c16_ + hh_ * 8; \
                if (OUT && second) rq[hh_][qk_] = GLD(u32x4, qkc + (size_t)(SC - 1 - ((J0) - scidx * SC + t_)) * 256 + qk_ * 128 + c16_ + hh_ * 8); \
                else if (OUT || qk_) { rq[hh_][qk_] = ldp8(P, row_, col_); rh[hh_][qk_] = ldp8(P, hrow_, col_); } } \
            rv[hh_] = GLD(u32x4, P + (size_t)row_ * PCOLS + PC_ML_V + head * 128 + c16_ + hh_ * 8); } \
        if (tid < 64) { const int r2_ = scan_row(b, dir, (J0) + tid, false); gi = GLD(float, G32 + (size_t)r2_ * 32 + 16 + dir * 4 + head); gf = GLD(float, G32 + (size_t)r2_ * 32 + 24 + dir * 4 + head); } } while (0)
    ML_LOAD(scidx * SC);
#pragma unroll 1
    for (int sub = 0; sub < SC / ml::T; ++sub) {
        const int j0 = scidx * SC + sub * ml::T;
        { const int t = tid >> 3, c16 = (tid & 7) * 16;
#pragma unroll
          for (int hh = 0; hh < 2; ++hh) { const int c8 = c16 + hh * 8;
#pragma unroll
              for (int qk = OUT ? 0 : 1; qk < 2; ++qk) { __builtin_amdgcn_sched_barrier(0);
                  if (OUT && second) { *(LAS u32x4*)((qk ? kb : qb) + t * 136 + c8) = rq[hh][qk]; continue; }
                  const u32x4 cur = rq[hh][qk], hal = rh[hh][qk]; u32x4 lo, hi;
                  lo.x = __shfl_up(cur.x, 8); lo.y = __shfl_up(cur.y, 8); lo.z = __shfl_up(cur.z, 8); lo.w = __shfl_up(cur.w, 8);
                  hi.x = __shfl_down(cur.x, 8); hi.y = __shfl_down(cur.y, 8); hi.z = __shfl_down(cur.z, 8); hi.w = __shfl_down(cur.w, 8);
                  if (lane < 8) lo = hal; if (lane >= 56) hi = hal;
                  float xm[8], x0[8], xp[8]; unpack8(dir ? hi : lo, xm); unpack8(cur, x0); unpack8(dir ? lo : hi, xp);
                  float o[8];
#pragma unroll
                  for (int j = 0; j < 8; ++j) { const int cl = qk * 128 + c8 + j; const float y = cwl[cl] * xm[j] + cwl[256 + cl] * x0[j] + cwl[512 + cl] * xp[j] + cwl[768 + cl]; o[j] = siluf_(y) * (qk ? 0.08838834764831845f : 1.0f); }
                  u32x4 wv; wv.x = cvt_pk_bf16(o[0], o[1]); wv.y = cvt_pk_bf16(o[2], o[3]); wv.z = cvt_pk_bf16(o[4], o[5]); wv.w = cvt_pk_bf16(o[6], o[7]);
                  *(LAS u32x4*)((qk ? kb : qb) + t * 136 + c8) = wv;
                  if (OUT) GST(u32x4, qkc + (size_t)(sub * ml::T + t) * 256 + qk * 128 + c8) = wv; }
              const unsigned vw[4] = {rv[hh].x, rv[hh].y, rv[hh].z, rv[hh].w};
#pragma unroll
              for (int j = 0; j < 8; ++j) vT[(c8 + j) * 72 + tphys<8, 4>(c8 + j, t)] = (bf16_t)((vw[j >> 1] >> ((j & 1) * 16)) & 0xFFFFu); }
          if (tid < 64) { sc[ml::LI + tid] = gi + ib; sc[ml::LF + tid] = logsigmoidf_(gf + fb); } }
        __syncthreads();
        if (sub + 1 < SC / ml::T) ML_LOAD(j0 + ml::T);
        u32x4 oraw[2]; f32x4 pk[4];
        oraw[0] = oraw[1] = (u32x4){0u, 0u, 0u, 0u}; pk[0] = pk[1] = pk[2] = pk[3] = (f32x4){0.f, 0.f, 0.f, 0.f};
        if (OUT && second) { const int t = tid >> 3, c16 = (tid & 7) * 16; const int jl = sub * ml::T + t, tl = dir ? (SC - 1 - jl) : jl;
            const float* sp = oscr + (size_t)tl * 128 + c16;
#pragma unroll
            for (int j = 0; j < 4; ++j) pk[j] = GLD(f32x4, sp + 4 * j);
            const bf16_t* gp = P + (size_t)scan_row(b, dir, j0 + t, false) * PCOLS + PC_ML_O + head * 128 + c16; oraw[0] = GLD(u32x4, gp); oraw[1] = GLD(u32x4, gp + 8); }
        { float x = sc[ml::LF + lane];
#pragma unroll
            for (int d = 1; d < 64; d <<= 1) { const float y = __shfl_up(x, d); if (lane >= d) x += y; }
            sc[ml::BC + lane] = x; WAVE_LDS_SYNC(); }
        const float btot = sc[ml::BC + 63];
        { const int s = tid >> 3, c16 = (tid & 7) * 16; const float ws = __expf(btot - sc[ml::BC + s] + sc[ml::LI + s]);
#pragma unroll
          for (int j = 0; j < 16; ++j) wkT[(c16 + j) * 72 + tphys<8, 4>(c16 + j, s)] = f2bf1(bf2f(kb[s * 136 + c16 + j]) * ws); }
        if (OUT) {
#pragma unroll
            for (int q = 0; q < 2; ++q) { const int idx = w * 2 + q, tt = idx >> 2, ss = idx & 3;
                f32x4 a = (f32x4){0.f, 0.f, 0.f, 0.f};
                if (ss <= tt) a = mma_nt(qb + tt * 16 * 136, 136, kb + ss * 16 * 136, 136, 128, a, lane);
                const int s = ss * 16 + (lane & 15); const float cs = sc[ml::LI + s] - sc[ml::BC + s];
#pragma unroll
                for (int r = 0; r < 4; ++r) { const int t = tt * 16 + (lane >> 4) * 4 + r;
                    Wm[t * 72 + s] = f2bf1(s <= t ? a[r] * __expf(sc[ml::BC + t] + cs) : 0.f); } } }
        __syncthreads();
        f32x4 res[5];
        if (OUT) { const int tt = w & 3;
#pragma unroll
            for (int i = 0; i < 5; ++i) { __builtin_amdgcn_sched_barrier(0); const int vt = (w >> 2) + 2 * i; res[i] = (f32x4){0.f, 0.f, 0.f, 0.f};
                if (vt < 9) { f32x4 a1 = mma_nt(Wm + tt * 16 * 72, 72, vT + vt * 16 * 72, 72, 64, (f32x4){0.f, 0.f, 0.f, 0.f}, lane, -1, vt);
                    f32x4 a2 = mma_nt(qb + tt * 16 * 136, 136, Cb + vt * 16 * 136, 136, 128, (f32x4){0.f, 0.f, 0.f, 0.f}, lane);
#pragma unroll
                    for (int r = 0; r < 4; ++r) { const int t = tt * 16 + (lane >> 4) * 4 + r; res[i][r] = a1[r] + __expf(sc[ml::BC + t]) * a2[r]; }
                    if (vt == 8 && (lane & 15) == 0) {
#pragma unroll
                        for (int r = 0; r < 4; ++r) sc[ml::DN + tt * 16 + (lane >> 4) * 4 + r] = res[i][r]; } } } }
        __syncthreads();
        if (OUT) { const int tt = w & 3;
#pragma unroll
            for (int i = 0; i < 5; ++i) { const int vt = (w >> 2) + 2 * i;
                if (vt < 8) {
#pragma unroll
                    for (int r = 0; r < 4; ++r) { const int t = tt * 16 + (lane >> 4) * 4 + r; ob[t * 132 + vt * 16 + (lane & 15)] = res[i][r]; } } } }
        { const float eb = __expf(btot);
#pragma unroll
          for (int vt = 0; vt < 9; ++vt) { __builtin_amdgcn_sched_barrier(0); f32x4 a = cacc[vt] * eb; a = mma_nt(vT + vt * 16 * 72, 72, wkT + w * 16 * 72, 72, 64, a, lane, vt, w); cacc[vt] = a;
              if (OUT) {
#pragma unroll
                  for (int r = 0; r < 4; ++r) Cb[(vt * 16 + (lane >> 4) * 4 + r) * 136 + w * 16 + (lane & 15)] = f2bf1(a[r]); } } }
        dec_log += btot;
        __syncthreads();
        if (OUT) { const int t = tid >> 3, c16 = (tid & 7) * 16; const int jl = sub * ml::T + t, tl = dir ? (SC - 1 - jl) : jl;
            float o[16];
            { const float dinv = __builtin_amdgcn_rcpf(fmaxf(fabsf(sc[ml::DN + t]), 1.0f));
#pragma unroll
              for (int j = 0; j < 16; ++j) o[j] = ob[t * 132 + c16 + j] * dinv; }
            float* sp = oscr + (size_t)tl * 128 + c16;
            if (!second) {
#pragma unroll
                for (int j = 0; j < 16; j += 4) GST(f32x4, sp + j) = (f32x4){o[j], o[j + 1], o[j + 2], o[j + 3]}; }
            else {
#pragma unroll
                for (int j = 0; j < 16; j += 4) { const f32x4 pv = pk[j >> 2]; o[j] += pv[0]; o[j + 1] += pv[1]; o[j + 2] += pv[2]; o[j + 3] += pv[3]; }
                float ss = 0.f;
#pragma unroll
                for (int j = 0; j < 16; ++j) ss += o[j] * o[j];
                ss += __shfl_xor(ss, 1); ss += __shfl_xor(ss, 2); ss += __shfl_xor(ss, 4);
                const float rstd = __builtin_amdgcn_rsqf(ss * (1.0f / 128.0f) + 1e-6f);
                const int row = scan_row(b, dir, j0 + t, false);
                const float* ng = inp(F, I_ML_NG) + (size_t)l * 512 + head * 128 + c16;
#pragma unroll
                for (int hh = 0; hh < 2; ++hh) { float g[8]; unpack8(oraw[hh], g);
                    float y[8];
#pragma unroll
                    for (int j = 0; j < 8; ++j) y[j] = o[hh * 8 + j] * rstd * ng[hh * 8 + j] * sigmoidf_(g[j]);
                    u32x4 wv; wv.x = cvt_pk_bf16(y[0], y[1]); wv.y = cvt_pk_bf16(y[2], y[3]); wv.z = cvt_pk_bf16(y[4], y[5]); wv.w = cvt_pk_bf16(y[6], y[7]);
                    GST(u32x4, WSP(bf16_t, wsmap::HYB) + (size_t)row * HY_LD + 1024 + 2 * 512 + head * 128 + c16 + hh * 8) = wv; } } }
        __syncthreads();
    }
}
__device__ __forceinline__ void ml_vt_ones(const Frame& F) {
    LAS bf16_t* vT = (LAS bf16_t*)(F.lds + ml::VT);
    for (int i = F.tid; i < 16 * 72; i += NTHREADS) vT[128 * 72 + i] = (bf16_t)((i < 72) ? 0x3F80u : 0u);
}
__device__ __forceinline__ void ml_m1_item(const Frame& F, int l, int it) {
    const int chain = it / NSC, sc = it % NSC, head = chain & 3, dir = (chain >> 2) & 1, b = chain >> 3;
    f32x4 cacc[9];
#pragma unroll
    for (int vt = 0; vt < 9; ++vt) cacc[vt] = (f32x4){0.f, 0.f, 0.f, 0.f};
    __syncthreads(); ml_vt_ones(F); __syncthreads();
    float dl = 0.f;
    ml_pass<false>(F, l, b, dir, head, sc, cacc, dl, false);
    { LAS float* stg = (LAS float*)F.lds; LAS float* sp = stg + ((F.lane >> 4) * 4) * 128 + F.wave * 16 + (F.lane & 15);
#pragma unroll
      for (int vt = 0; vt < 9; ++vt)
#pragma unroll
          for (int r = 0; r < 4; ++r) sp[(vt * 16 + r) * 128] = cacc[vt][r];
      __syncthreads();
      copy_l2g(F, stg, WSP(bf16_t, wsmap::ST_ML) + (size_t)it * 144 * 128, 144 * 128); }
    if (F.tid == 0) WSP(float, wsmap::DEC_ML)[it] = __expf(dl);
}
__device__ __forceinline__ void ml_m3_item(const Frame& F, int l, int it) {
    const int c = it % NSC, bh = it / NSC, head = bh & 3, b = bh >> 2;
    f32x4 cacc[9];
#pragma unroll
    for (int dir = 0; dir < 2; ++dir) { const int scidx = dir ? sc_mirror(c) : c; const int chain = (b * 2 + dir) * 4 + head;
        LAS float* stg = (LAS float*)F.lds; LAS bf16_t* Cb = (LAS bf16_t*)(F.lds + ml::CB);
        __syncthreads();
        copy_g2l(F, WSP(bf16_t, wsmap::ST_ML) + ((size_t)chain * NSC + scidx) * 144 * 128, stg, 144 * 128);
        __syncthreads();
        { const LAS float* sp = stg + ((F.lane >> 4) * 4) * 128 + F.wave * 16 + (F.lane & 15); LAS bf16_t* bp = Cb + ((F.lane >> 4) * 4) * 136 + F.wave * 16 + (F.lane & 15);
#pragma unroll
          for (int vt = 0; vt < 9; ++vt)
#pragma unroll
              for (int r = 0; r < 4; ++r) { const float x = sp[(vt * 16 + r) * 128]; cacc[vt][r] = x; bp[(vt * 16 + r) * 136] = f2bf1(x); } }
        __syncthreads();
        ml_vt_ones(F);
        __syncthreads();
        float dl = 0.f;
        ml_pass<true>(F, l, b, dir, head, scidx, cacc, dl, dir == 1); }
}

namespace sd { constexpr int T = 64, CM = 0, BM = 9216, XT = 18432, WXT = 27648, BTR = 36864, SCM = 46080, HB = 55296, OB = 64512, SCAL = 81920, CWL = 83968, END = 87040;
    constexpr int ACS = 0, DT = 64, DA = 128; }
template <bool OUT> __device__ __forceinline__ void sd_pass(const Frame& F, int l, int b, int dir, int head, int scidx, f32x4 (&hacc)[2], float& dec_log, bool second) {
    LAS unsigned char* L = F.lds; const int tid = F.tid, lane = F.lane, w = F.wave, grp = head >> 2;
    LAS bf16_t* Cm = (LAS bf16_t*)(L + sd::CM); LAS bf16_t* Bm = (LAS bf16_t*)(L + sd::BM); LAS bf16_t* xT = (LAS bf16_t*)(L + sd::XT); LAS bf16_t* wxT = (LAS bf16_t*)(L + sd::WXT);
    LAS bf16_t* BT = (LAS bf16_t*)(L + sd::BTR); LAS bf16_t* Scm = (LAS bf16_t*)(L + sd::SCM); LAS bf16_t* Hb = (LAS bf16_t*)(L + sd::HB); LAS float* ob = (LAS float*)(L + sd::OB);
    LAS float* sc = (LAS float*)(L + sd::SCAL);
    const bf16_t* P = WSP(bf16_t, wsmap::P); const float* G32 = WSP(float, wsmap::G32);
    const float* cw = inp(F, I_SSD_CW) + (size_t)l * 3 * 768; const float* cb = inp(F, I_SSD_CB) + (size_t)l * 768;
    const float dtb = inp(F, I_SSD_DTB)[(l * 2 + dir) * 8 + head], Aneg = -__expf(inp(F, I_SSD_ALOG)[(l * 2 + dir) * 8 + head]);
    float* oscr = wg_scratch(F);
    bf16_t* xbc = (bf16_t*)((unsigned char*)oscr + 131072);
    LAS float* cwl = (LAS float*)(L + sd::CWL);
    for (int i = tid; i < 768; i += NTHREADS) { const int j = i / 192, qc = i % 192, ch = (qc < 64 ? head * 64 + qc : qc < 128 ? 512 + grp * 64 + (qc - 64) : 640 + grp * 64 + (qc - 128));
        cwl[i] = j < 3 ? cw[j * 768 + ch] : cb[ch]; }
    __syncthreads();
    u32x4 raw[3][3]; float dtr = 0.f;
#define SD_LOAD(J0) do { const int t_ = tid >> 3, c8_ = (tid & 7) * 8; const int row_ = scan_row(b, dir, (J0) + t_, false), rp_ = row_prev(row_), rn_ = row_next(row_); \
        _Pragma("unroll") for (int wh_ = 0; wh_ < 3; ++wh_) { const int col_ = (wh_ == 0 ? PC_SSD_X + head * 64 : wh_ == 1 ? PC_SSD_B + grp * 64 : PC_SSD_C + grp * 64) + c8_; \
            if (OUT && second) raw[wh_][1] = GLD(u32x4, xbc + (size_t)(SC - 1 - ((J0) - scidx * SC + t_)) * 192 + wh_ * 64 + c8_); \
            else if (OUT || wh_ != 2) { raw[wh_][0] = ldp8(P, rp_, col_); raw[wh_][1] = ldp8(P, row_, col_); raw[wh_][2] = ldp8(P, rn_, col_); } } \
        if (tid < 64) dtr = GLD(float, G32 + (size_t)scan_row(b, dir, (J0) + tid, false) * 32 + dir * 8 + head); } while (0)
    SD_LOAD(scidx * SC);
#pragma unroll 1
    for (int sub = 0; sub < SC / sd::T; ++sub) {
        const int j0 = scidx * SC + sub * sd::T;
        { const int t = tid >> 3, c8 = (tid & 7) * 8;
#pragma unroll
          for (int which = 0; which < (OUT ? 3 : 2); ++which) { __builtin_amdgcn_sched_barrier(0);
              const int cl = which * 64 + c8;
              u32x4 wv;
              if (OUT && second) wv = raw[which][1];
              else { float xm[8], x0[8], xp[8]; unpack8(raw[which][0], xm); unpack8(raw[which][1], x0); unpack8(raw[which][2], xp);
                  float o[8];
#pragma unroll
                  for (int j = 0; j < 8; ++j) o[j] = siluf_(cwl[cl + j] * xm[j] + cwl[192 + cl + j] * x0[j] + cwl[384 + cl + j] * xp[j] + cwl[576 + cl + j]);
                  wv.x = cvt_pk_bf16(o[0], o[1]); wv.y = cvt_pk_bf16(o[2], o[3]); wv.z = cvt_pk_bf16(o[4], o[5]); wv.w = cvt_pk_bf16(o[6], o[7]);
                  if (OUT) GST(u32x4, xbc + (size_t)(sub * sd::T + t) * 192 + which * 64 + c8) = wv; }
              const unsigned hw[4] = {wv.x, wv.y, wv.z, wv.w};
              if (which == 0) {
#pragma unroll
                  for (int j = 0; j < 8; ++j) xT[(c8 + j) * 72 + tphys<8, 3>(c8 + j, t)] = (bf16_t)((hw[j >> 1] >> ((j & 1) * 16)) & 0xFFFFu); }
              else { *(LAS u32x4*)((which == 1 ? Bm : Cm) + t * 72 + c8) = wv;
                  if (which == 1) {
#pragma unroll
                      for (int j = 0; j < 8; ++j) BT[(c8 + j) * 72 + tphys<8, 3>(c8 + j, t)] = (bf16_t)((hw[j >> 1] >> ((j & 1) * 16)) & 0xFFFFu); } } }
          if (tid < 64) { const float dt = softplusf_(dtr + dtb); sc[sd::DT + tid] = dt; sc[sd::DA + tid] = dt * Aneg; } }
        __syncthreads();
        if (sub + 1 < SC / sd::T) SD_LOAD(j0 + sd::T);
        u32x4 zraw = (u32x4){0u, 0u, 0u, 0u}; f32x4 pk0 = (f32x4){0.f, 0.f, 0.f, 0.f}, pk1 = pk0;
        if (OUT && second) { const int t = tid >> 3, c8 = (tid & 7) * 8; const int jl = sub * sd::T + t, tl = dir ? (SC - 1 - jl) : jl;
            const float* sp = oscr + (size_t)tl * 64 + c8; pk0 = GLD(f32x4, sp); pk1 = GLD(f32x4, sp + 4);
            zraw = GLD(u32x4, P + (size_t)scan_row(b, dir, j0 + t, false) * PCOLS + PC_SSD_Z + head * 64 + c8); }
        __syncthreads();
        { float x = sc[sd::DA + lane];
#pragma unroll
            for (int d = 1; d < 64; d <<= 1) { const float y = __shfl_up(x, d); if (lane >= d) x += y; }
            sc[sd::ACS + lane] = x; WAVE_LDS_SYNC(); }
        const float aend = sc[sd::ACS + 63];
        { const int s = tid >> 3, c8 = (tid & 7) * 8; const float ws = __expf(aend - sc[sd::ACS + s]) * sc[sd::DT + s];
#pragma unroll
          for (int j = 0; j < 8; ++j) { const int pi = (c8 + j) * 72 + tphys<8, 3>(c8 + j, s); wxT[pi] = f2bf1(bf2f(xT[pi]) * ws); } }
        if (OUT) {
#pragma unroll
            for (int q = 0; q < 2; ++q) { const int idx = w * 2 + q, tt = idx >> 2, ss = idx & 3;
                f32x4 a = (f32x4){0.f, 0.f, 0.f, 0.f};
                if (ss <= tt) a = mma_nt(Cm + tt * 16 * 72, 72, Bm + ss * 16 * 72, 72, 64, a, lane);
                const int s = ss * 16 + (lane & 15); const float as = sc[sd::ACS + s], ds = sc[sd::DT + s];
#pragma unroll
                for (int r = 0; r < 4; ++r) { const int t = tt * 16 + (lane >> 4) * 4 + r;
                    Scm[t * 72 + s] = f2bf1(s <= t ? a[r] * __expf(sc[sd::ACS + t] - as) * ds : 0.f); } } }
        __syncthreads();
        if (OUT) {
#pragma unroll
            for (int q = 0; q < 2; ++q) { const int idx = w * 2 + q, tt = idx >> 2, pt = idx & 3;
                f32x4 a1 = mma_nt(Scm + tt * 16 * 72, 72, xT + pt * 16 * 72, 72, 64, (f32x4){0.f, 0.f, 0.f, 0.f}, lane, -1, (pt * 16 + (lane & 15)) >> 3);
                f32x4 a2 = mma_nt(Cm + tt * 16 * 72, 72, Hb + pt * 16 * 72, 72, 64, (f32x4){0.f, 0.f, 0.f, 0.f}, lane);
#pragma unroll
                for (int r = 0; r < 4; ++r) { const int t = tt * 16 + (lane >> 4) * 4 + r; ob[t * 68 + pt * 16 + (lane & 15)] = a1[r] + __expf(sc[sd::ACS + t]) * a2[r]; } } }
        __syncthreads();
        { const float ea = __expf(aend);
#pragma unroll
          for (int q = 0; q < 2; ++q) { const int idx = w * 2 + q, pt = idx >> 2, nt = idx & 3;
              f32x4 a = hacc[q] * ea; a = mma_nt(wxT + pt * 16 * 72, 72, BT + nt * 16 * 72, 72, 64, a, lane, (pt * 16 + (lane & 15)) >> 3, (nt * 16 + (lane & 15)) >> 3); hacc[q] = a;
              if (OUT) {
#pragma unroll
                  for (int r = 0; r < 4; ++r) Hb[(pt * 16 + (lane >> 4) * 4 + r) * 72 + nt * 16 + (lane & 15)] = f2bf1(a[r]); } } }
        dec_log += aend;
        if (OUT) { const int t = tid >> 3, c8 = (tid & 7) * 8; const int jl = sub * sd::T + t, tl = dir ? (SC - 1 - jl) : jl;
            float o[8];
#pragma unroll
            for (int j = 0; j < 8; ++j) o[j] = ob[t * 68 + c8 + j];
            float* sp = oscr + (size_t)tl * 64 + c8;
            if (!second) { GST(f32x4, sp) = (f32x4){o[0], o[1], o[2], o[3]}; GST(f32x4, sp + 4) = (f32x4){o[4], o[5], o[6], o[7]}; }
            else { const f32x4 p0 = pk0, p1 = pk1;
                o[0] += p0[0]; o[1] += p0[1]; o[2] += p0[2]; o[3] += p0[3]; o[4] += p1[0]; o[5] += p1[1]; o[6] += p1[2]; o[7] += p1[3];
                const int row = scan_row(b, dir, j0 + t, false); const float dsk = inp(F, I_SSD_D)[l * 8 + head];
                float z[8]; unpack8(zraw, z);
                const float* ng = inp(F, I_SSD_NG) + (size_t)l * 512 + head * 64 + c8;
                float ss = 0.f, y[8];
#pragma unroll
                for (int j = 0; j < 8; ++j) { const float g = (o[j] + dsk * bf2f(xT[(c8 + j) * 72 + tphys<8, 3>(c8 + j, t)])) * siluf_(z[j]); ss += g * g; y[j] = g * ng[j]; }
                ss += __shfl_xor(ss, 1); ss += __shfl_xor(ss, 2); ss += __shfl_xor(ss, 4);
                if ((tid & 7) == 0) GST(float, WSP(float, wsmap::SSQ) + (size_t)row * 8 + head) = ss;
                u32x4 wv; wv.x = cvt_pk_bf16(y[0], y[1]); wv.y = cvt_pk_bf16(y[2], y[3]); wv.z = cvt_pk_bf16(y[4], y[5]); wv.w = cvt_pk_bf16(y[6], y[7]);
                GST(u32x4, WSP(bf16_t, wsmap::HYB) + (size_t)row * HY_LD + 1024 + head * 64 + c8) = wv; } }
        __syncthreads();
    }
}
__device__ __forceinline__ void sd_m1_item(const Frame& F, int l, int it) {
    const int chain = it / NSC, sc = it % NSC, head = chain & 7, dir = (chain >> 3) & 1, b = chain >> 4;
    f32x4 hacc[2] = {(f32x4){0.f, 0.f, 0.f, 0.f}, (f32x4){0.f, 0.f, 0.f, 0.f}};
    float dl = 0.f;
    __syncthreads();
    sd_pass<false>(F, l, b, dir, head, sc, hacc, dl, false);
    { LAS float* stg = (LAS float*)(F.lds + sd::OB);
#pragma unroll
      for (int q = 0; q < 2; ++q) { const int idx = F.wave * 2 + q, pt = idx >> 2, nt = idx & 3;
#pragma unroll
          for (int r = 0; r < 4; ++r) stg[(pt * 16 + (F.lane >> 4) * 4 + r) * 64 + nt * 16 + (F.lane & 15)] = hacc[q][r]; }
      __syncthreads();
      copy_l2g(F, stg, WSP(bf16_t, wsmap::ST_SSD) + (size_t)it * 4096, 4096); }
    if (F.tid == 0) WSP(float, wsmap::DEC_SSD)[it] = __expf(dl);
}
__device__ __forceinline__ void sd_m3_item(const Frame& F, int l, int it) {
    const int c = it % NSC, bh = it / NSC, head = bh & 7, b = bh >> 3;
    f32x4 hacc[2];
#pragma unroll
    for (int dir = 0; dir < 2; ++dir) { const int scidx = dir ? sc_mirror(c) : c; const int chain = (b * 2 + dir) * 8 + head;
        LAS bf16_t* Hb = (LAS bf16_t*)(F.lds + sd::HB); LAS float* stg = (LAS float*)(F.lds + sd::OB);
        __syncthreads();
        copy_g2l(F, WSP(bf16_t, wsmap::ST_SSD) + ((size_t)chain * NSC + scidx) * 4096, stg, 4096);
        __syncthreads();
#pragma unroll
        for (int q = 0; q < 2; ++q) { const int idx = F.wave * 2 + q, pt = idx >> 2, nt = idx & 3;
#pragma unroll
            for (int r = 0; r < 4; ++r) { const int p = pt * 16 + (F.lane >> 4) * 4 + r, n = nt * 16 + (F.lane & 15); const float x = stg[p * 64 + n]; hacc[q][r] = x; Hb[p * 72 + n] = f2bf1(x); } }
        __syncthreads();
        float dl = 0.f;
        sd_pass<true>(F, l, b, dir, head, scidx, hacc, dl, dir == 1); }
}
__device__ __forceinline__ void ml_m1f_item(const Frame& F, int l, int it) {
    const int c = it % NSC, bh = it / NSC, head = bh & 3, b = bh >> 2;
    LAS unsigned char* L = F.lds; const int tid = F.tid, lane = F.lane, w = F.wave;
    LAS bf16_t* kb = (LAS bf16_t*)(L + ml::KB); LAS bf16_t* vT = (LAS bf16_t*)(L + ml::VT); LAS bf16_t* wkF = (LAS bf16_t*)(L + ml::WKT); LAS bf16_t* wkB = (LAS bf16_t*)(L + ml::CB);
    LAS float* sc = (LAS float*)(L + ml::SCAL); LAS float* cwl = (LAS float*)(L + ml::CWL);
    constexpr int BCF = 0, LIF = 64, EXB = 128, LFF = 192, LIB = 256, LFB = 320;
    const bf16_t* P = WSP(bf16_t, wsmap::P); const float* G32 = WSP(float, wsmap::G32);
    const float* cw = inp(F, I_ML_CW) + (size_t)l * 3 * 1024; const float* cb = inp(F, I_ML_CB) + (size_t)l * 1024;
    const float ibf = inp(F, I_ML_IB)[(l * 2 + 0) * 4 + head], ibb = inp(F, I_ML_IB)[(l * 2 + 1) * 4 + head];
    const float fbf = inp(F, I_ML_FB)[(l * 2 + 0) * 4 + head], fbb = inp(F, I_ML_FB)[(l * 2 + 1) * 4 + head];
    f32x4 cf[9], cbw[9];
#pragma unroll
    for (int vt = 0; vt < 9; ++vt) { cf[vt] = (f32x4){0.f, 0.f, 0.f, 0.f}; cbw[vt] = cf[vt]; }
    __syncthreads();
    ml_vt_ones(F);
    if (tid < 256) { const int qc = 128 + (tid & 127), j = tid >> 7, ch = 512 + head * 128 + (tid & 127);
        cwl[j * 256 + qc] = cw[j * 1024 + ch]; cwl[(j + 2) * 256 + qc] = j ? cb[ch] : cw[2048 + ch]; }
    __syncthreads();
    u32x4 rk[2], rkh[2], rv[2]; float g4[4] = {0.f, 0.f, 0.f, 0.f};
#define MLF_LOAD(J0) do { const int t_ = tid >> 3, c16_ = (tid & 7) * 16; const int row_ = scan_row(b, 0, (J0) + t_, false); \
        const int hrow_ = lane < 8 ? row_prev(row_) : (lane >= 56 ? row_next(row_) : -1); \
        _Pragma("unroll") for (int hh_ = 0; hh_ < 2; ++hh_) { rk[hh_] = ldp8(P, row_, PC_ML_K + head * 128 + c16_ + hh_ * 8); rkh[hh_] = ldp8(P, hrow_, PC_ML_K + head * 128 + c16_ + hh_ * 8); rv[hh_] = GLD(u32x4, P + (size_t)row_ * PCOLS + PC_ML_V + head * 128 + c16_ + hh_ * 8); } \
        if (tid < 64) { const float* gp_ = G32 + (size_t)scan_row(b, 0, (J0) + tid, false) * 32 + 16 + head; g4[0] = GLD(float, gp_); g4[1] = GLD(float, gp_ + 4); g4[2] = GLD(float, gp_ + 8); g4[3] = GLD(float, gp_ + 12); } } while (0)
    MLF_LOAD(c * SC);
    float offb = 0.f, declf = 0.f;
#pragma unroll 1
    for (int sub = 0; sub < SC / ml::T; ++sub) {
        const int j0 = c * SC + sub * ml::T;
        { const int t = tid >> 3, c16 = (tid & 7) * 16;
#pragma unroll
          for (int hh = 0; hh < 2; ++hh) { __builtin_amdgcn_sched_barrier(0); const int c8 = c16 + hh * 8;
              const u32x4 cur = rk[hh], hal = rkh[hh]; u32x4 lo, hi;
              lo.x = __shfl_up(cur.x, 8); lo.y = __shfl_up(cur.y, 8); lo.z = __shfl_up(cur.z, 8); lo.w = __shfl_up(cur.w, 8);
              hi.x = __shfl_down(cur.x, 8); hi.y = __shfl_down(cur.y, 8); hi.z = __shfl_down(cur.z, 8); hi.w = __shfl_down(cur.w, 8);
              if (lane < 8) lo = hal; if (lane >= 56) hi = hal;
              float xm[8], x0[8], xp[8]; unpack8(lo, xm); unpack8(cur, x0); unpack8(hi, xp);
              float o[8];
#pragma unroll
              for (int j = 0; j < 8; ++j) { const int cl = 128 + c8 + j; o[j] = siluf_(cwl[cl] * xm[j] + cwl[256 + cl] * x0[j] + cwl[512 + cl] * xp[j] + cwl[768 + cl]) * 0.08838834764831845f; }
              u32x4 wv; wv.x = cvt_pk_bf16(o[0], o[1]); wv.y = cvt_pk_bf16(o[2], o[3]); wv.z = cvt_pk_bf16(o[4], o[5]); wv.w = cvt_pk_bf16(o[6], o[7]);
              *(LAS u32x4*)(kb + t * 136 + c8) = wv;
              const unsigned vw[4] = {rv[hh].x, rv[hh].y, rv[hh].z, rv[hh].w};
#pragma unroll
              for (int j = 0; j < 8; ++j) vT[(c8 + j) * 72 + tphys<8, 4>(c8 + j, t)] = (bf16_t)((vw[j >> 1] >> ((j & 1) * 16)) & 0xFFFFu); }
          if (tid < 64) { sc[LIF + tid] = g4[0] + ibf; sc[LIB + tid] = g4[1] + ibb; sc[LFF + tid] = logsigmoidf_(g4[2] + fbf); sc[LFB + tid] = logsigmoidf_(g4[3] + fbb); } }
        __syncthreads();
        if (sub + 1 < SC / ml::T) MLF_LOAD(j0 + ml::T);
        float btot, totb;
        { float xf = sc[LFF + lane], xb = sc[LFB + lane]; const float ownb = xb;
#pragma unroll
          for (int d = 1; d < 64; d <<= 1) { const float yf = __shfl_up(xf, d), yb = __shfl_up(xb, d); if (lane >= d) { xf += yf; xb += yb; } }
          sc[BCF + lane] = xf; sc[EXB + lane] = xb - ownb; WAVE_LDS_SYNC();
          btot = sc[BCF + 63]; totb = sc[EXB + 63] + sc[LFB + 63]; }
        { const int s = tid >> 3, c16 = (tid & 7) * 16; const float wf = __expf(btot - sc[BCF + s] + sc[LIF + s]), wb = __expf(offb + sc[EXB + s] + sc[LIB + s]);
#pragma unroll
          for (int j = 0; j < 16; ++j) { const float kv = bf2f(kb[s * 136 + c16 + j]); const int pi = (c16 + j) * 72 + tphys<8, 4>(c16 + j, s); wkF[pi] = f2bf1(kv * wf); wkB[pi] = f2bf1(kv * wb); } }
        __syncthreads();
        { const float eb = __expf(btot);
#pragma unroll
          for (int vt = 0; vt < 9; ++vt) { if (vt % 3 == 0) __builtin_amdgcn_sched_barrier(0);
              f32x4 a = cf[vt] * eb; a = mma_nt(vT + vt * 16 * 72, 72, wkF + w * 16 * 72, 72, 64, a, lane, vt, w); cf[vt] = a;
              cbw[vt] = mma_nt(vT + vt * 16 * 72, 72, wkB + w * 16 * 72, 72, 64, cbw[vt], lane, vt, w); } }
        declf += btot; offb += totb;
        __syncthreads();
    }
#undef MLF_LOAD
#pragma unroll
    for (int dir = 0; dir < 2; ++dir) { const int chain = (b * 2 + dir) * 4 + head, scidx = dir ? sc_mirror(c) : c;
        LAS float* stg = (LAS float*)F.lds; LAS float* sp = stg + ((lane >> 4) * 4) * 128 + w * 16 + (lane & 15);
        __syncthreads();
#pragma unroll
        for (int vt = 0; vt < 9; ++vt)
#pragma unroll
            for (int r = 0; r < 4; ++r) sp[(vt * 16 + r) * 128] = dir ? cbw[vt][r] : cf[vt][r];
        __syncthreads();
        copy_l2g(F, stg, WSP(bf16_t, wsmap::ST_ML) + ((size_t)chain * NSC + scidx) * 144 * 128, 144 * 128);
        if (tid == 0) WSP(float, wsmap::DEC_ML)[(size_t)chain * NSC + scidx] = __expf(dir ? offb : declf); }
}
__device__ __forceinline__ void sd_m1f_item(const Frame& F, int l, int it) {
    const int c = it % NSC, bh = it / NSC, head = bh & 7, b = bh >> 3, grp = head >> 2;
    LAS unsigned char* L = F.lds; const int tid = F.tid, lane = F.lane, w = F.wave;
    LAS bf16_t* xT = (LAS bf16_t*)(L + sd::XT); LAS bf16_t* wxF = (LAS bf16_t*)(L + sd::WXT); LAS bf16_t* wxB = (LAS bf16_t*)(L + sd::SCM); LAS bf16_t* BT = (LAS bf16_t*)(L + sd::BTR);
    LAS float* sc = (LAS float*)(L + sd::SCAL); LAS float* cwl = (LAS float*)(L + sd::CWL);
    constexpr int ACF = 0, DTF = 64, DAF = 128, EXB = 192, DTB = 256, DAB = 320;
    const bf16_t* P = WSP(bf16_t, wsmap::P); const float* G32 = WSP(float, wsmap::G32);
    const float* cw = inp(F, I_SSD_CW) + (size_t)l * 3 * 768; const float* cb = inp(F, I_SSD_CB) + (size_t)l * 768;
    const float dtbf = inp(F, I_SSD_DTB)[(l * 2 + 0) * 8 + head], dtbb = inp(F, I_SSD_DTB)[(l * 2 + 1) * 8 + head];
    const float Af = -__expf(inp(F, I_SSD_ALOG)[(l * 2 + 0) * 8 + head]), Ab = -__expf(inp(F, I_SSD_ALOG)[(l * 2 + 1) * 8 + head]);
    f32x4 hf[2], hb[2];
#pragma unroll
    for (int q = 0; q < 2; ++q) { hf[q] = (f32x4){0.f, 0.f, 0.f, 0.f}; hb[q] = hf[q]; }
    __syncthreads();
    for (int i = tid; i < 768; i += NTHREADS) { const int j = i / 192, qc = i % 192, ch = (qc < 64 ? head * 64 + qc : qc < 128 ? 512 + grp * 64 + (qc - 64) : 640 + grp * 64 + (qc - 128));
        cwl[i] = j < 3 ? cw[j * 768 + ch] : cb[ch]; }
    __syncthreads();
    u32x4 raw[2][3]; float d2[2] = {0.f, 0.f};
#define SDF_LOAD(J0) do { const int t_ = tid >> 3, c8_ = (tid & 7) * 8; const int row_ = scan_row(b, 0, (J0) + t_, false), rp_ = row_prev(row_), rn_ = row_next(row_); \
        _Pragma("unroll") for (int wh_ = 0; wh_ < 2; ++wh_) { const int col_ = (wh_ == 0 ? PC_SSD_X + head * 64 : PC_SSD_B + grp * 64) + c8_; \
            raw[wh_][0] = ldp8(P, rp_, col_); raw[wh_][1] = ldp8(P, row_, col_); raw[wh_][2] = ldp8(P, rn_, col_); } \
        if (tid < 64) { const float* gp_ = G32 + (size_t)scan_row(b, 0, (J0) + tid, false) * 32 + head; d2[0] = GLD(float, gp_); d2[1] = GLD(float, gp_ + 8); } } while (0)
    SDF_LOAD(c * SC);
    float offb = 0.f, declf = 0.f;
#pragma unroll 1
    for (int sub = 0; sub < SC / sd::T; ++sub) {
        const int j0 = c * SC + sub * sd::T;
        { const int t = tid >> 3, c8 = (tid & 7) * 8;
#pragma unroll
          for (int which = 0; which < 2; ++which) { __builtin_amdgcn_sched_barrier(0);
              const int cl = which * 64 + c8;
              float xm[8], x0[8], xp[8]; unpack8(raw[which][0], xm); unpack8(raw[which][1], x0); unpack8(raw[which][2], xp);
#pragma unroll
              for (int j = 0; j < 8; ++j) { const float o = siluf_(cwl[cl + j] * xm[j] + cwl[192 + cl + j] * x0[j] + cwl[384 + cl + j] * xp[j] + cwl[576 + cl + j]);
                  (which ? BT : xT)[(c8 + j) * 72 + tphys<8, 3>(c8 + j, t)] = f2bf1(o); } }
          if (tid < 64) { const float dtf = softplusf_(d2[0] + dtbf), dtb2 = softplusf_(d2[1] + dtbb);
              sc[DTF + tid] = dtf; sc[DAF + tid] = dtf * Af; sc[DTB + tid] = dtb2; sc[DAB + tid] = dtb2 * Ab; } }
        __syncthreads();
        if (sub + 1 < SC / sd::T) SDF_LOAD(j0 + sd::T);
        float aend, totb;
        { float xf = sc[DAF + lane], xb = sc[DAB + lane]; const float ownb = xb;
#pragma unroll
          for (int d = 1; d < 64; d <<= 1) { const float yf = __shfl_up(xf, d), yb = __shfl_up(xb, d); if (lane >= d) { xf += yf; xb += yb; } }
          sc[ACF + lane] = xf; sc[EXB + lane] = xb - ownb; WAVE_LDS_SYNC();
          aend = sc[ACF + 63]; totb = sc[EXB + 63] + sc[DAB + 63]; }
        { const int s = tid >> 3, c8 = (tid & 7) * 8; const float wf = __expf(aend - sc[ACF + s]) * sc[DTF + s], wb = __expf(offb + sc[EXB + s]) * sc[DTB + s];
#pragma unroll
          for (int j = 0; j < 8; ++j) { const int pi = (c8 + j) * 72 + tphys<8, 3>(c8 + j, s); const float xv = bf2f(xT[pi]); wxF[pi] = f2bf1(xv * wf); wxB[pi] = f2bf1(xv * wb); } }
        __syncthreads();
        { const float ea = __expf(aend);
#pragma unroll
          for (int q = 0; q < 2; ++q) { const int idx = w * 2 + q, pt = idx >> 2, nt = idx & 3; const int ra = (pt * 16 + (lane & 15)) >> 3, rb = (nt * 16 + (lane & 15)) >> 3;
              f32x4 a = hf[q] * ea; a = mma_nt(wxF + pt * 16 * 72, 72, BT + nt * 16 * 72, 72, 64, a, lane, ra, rb); hf[q] = a;
              hb[q] = mma_nt(wxB + pt * 16 * 72, 72, BT + nt * 16 * 72, 72, 64, hb[q], lane, ra, rb); } }
        declf += aend; offb += totb;
        __syncthreads();
    }
#undef SDF_LOAD
#pragma unroll
    for (int dir = 0; dir < 2; ++dir) { const int chain = (b * 2 + dir) * 8 + head, scidx = dir ? sc_mirror(c) : c;
        LAS float* stg = (LAS float*)(F.lds + sd::OB);
        __syncthreads();
#pragma unroll
        for (int q = 0; q < 2; ++q) { const int idx = w * 2 + q, pt = idx >> 2, nt = idx & 3;
#pragma unroll
            for (int r = 0; r < 4; ++r) stg[(pt * 16 + (lane >> 4) * 4 + r) * 64 + nt * 16 + (lane & 15)] = dir ? hb[q][r] : hf[q][r]; }
        __syncthreads();
        copy_l2g(F, stg, WSP(bf16_t, wsmap::ST_SSD) + ((size_t)chain * NSC + scidx) * 4096, 4096);
        if (tid == 0) WSP(float, wsmap::DEC_SSD)[(size_t)chain * NSC + scidx] = __expf(dir ? offb : declf); }
}
namespace hgf { constexpr int T = 32, KFF = 0, KFB = 16896, BFF = 33792, BFB = 50688, VT = 67584, KTF = 77824, KTB = 88064, BTOT = 98304, OFFB = 98816, TOTB = 99328, SEG = 99840, END = 103936; }
__device__ __forceinline__ void hg_m1f_item(const Frame& F, int l, int it) {
    const int c = it % NSC, bh = it / NSC, head = bh & 3, b = bh >> 2;
    LAS unsigned char* L = F.lds; const int tid = F.tid, lane = F.lane, w = F.wave;
    LAS float* kff = (LAS float*)(L + hgf::KFF); LAS float* kfb = (LAS float*)(L + hgf::KFB); LAS float* bff = (LAS float*)(L + hgf::BFF); LAS float* bfb = (LAS float*)(L + hgf::BFB);
    LAS bf16_t* vT = (LAS bf16_t*)(L + hgf::VT); LAS bf16_t* kTf = (LAS bf16_t*)(L + hgf::KTF); LAS bf16_t* kTb = (LAS bf16_t*)(L + hgf::KTB);
    LAS float* btot = (LAS float*)(L + hgf::BTOT); LAS float* offb = (LAS float*)(L + hgf::OFFB); LAS float* totb = (LAS float*)(L + hgf::TOTB); LAS float* seg = (LAS float*)(L + hgf::SEG);
    const bf16_t* P = WSP(bf16_t, wsmap::P); const float* lbp = WSP(float, wsmap::LB) + l * 512 + head * 128;
    f32x4 sf[8], sb[8];
#pragma unroll
    for (int kt = 0; kt < 8; ++kt) { sf[kt] = (f32x4){0.f, 0.f, 0.f, 0.f}; sb[kt] = sf[kt]; }
    __syncthreads();
    if (tid < 128) { offb[tid] = 0.f; btot[tid] = 0.f; }
    LAS float* fsum = (LAS float*)(L + hgf::SEG + 2048 + 1024);
    if (tid < 128) fsum[tid] = 0.f;
    __syncthreads();
    float lbv[8];
#pragma unroll
    for (int j = 0; j < 8; ++j) lbv[j] = GLD(float, lbp + (tid & 15) * 8 + j);
    u32x4 rff, rfb, rv;
    { const bf16_t* pr = P + (size_t)scan_row(b, 0, c * SC + (tid >> 4), true) * PCOLS + head * 128 + (tid & 15) * 8;
      rff = GLD(u32x4, pr + PC_HG_FF); rfb = GLD(u32x4, pr + PC_HG_FB); rv = GLD(u32x4, pr + PC_HG_I); }
#pragma unroll 1
    for (int sub = 0; sub < SC / hgf::T; ++sub) {
        const int j0 = c * SC + sub * hgf::T;
        { const int t = tid >> 4, c8 = (tid & 15) * 8;
          float ff[8], fb[8];
          unpack8(rff, ff); unpack8(rfb, fb);
          const u32x4 vraw = rv;
          if (sub + 1 < SC / hgf::T) { const bf16_t* pr = P + (size_t)scan_row(b, 0, j0 + hgf::T + t, true) * PCOLS + head * 128 + c8;
              rff = GLD(u32x4, pr + PC_HG_FF); rfb = GLD(u32x4, pr + PC_HG_FB); rv = GLD(u32x4, pr + PC_HG_I); }
#pragma unroll
          for (int j = 0; j < 8; ++j) { const float lb = lbv[j], sgf = sigmoidf_(ff[j]), sgb = sigmoidf_(fb[j]); const float lbc = fmaxf(lb, 1e-30f), ub = 1.0f - lb;
              kff[t * 132 + c8 + j] = ub * (1.0f - sgf); kfb[t * 132 + c8 + j] = ub * (1.0f - sgb);
              bff[t * 132 + c8 + j] = __logf(lbc + ub * sgf); bfb[t * 132 + c8 + j] = __logf(lbc + ub * sgb); }
          const unsigned vw[4] = {vraw.x, vraw.y, vraw.z, vraw.w};
#pragma unroll
          for (int j = 0; j < 8; ++j) vT[(c8 + j) * 40 + tphys<4, 3>(c8 + j, t)] = (bf16_t)((vw[j >> 1] >> ((j & 1) * 16)) & 0xFFFFu); }
        __syncthreads();
        { const int k = tid & 127, sg = tid >> 7;
          float vf[8], vb[8]; float rf = 0.f, rb = 0.f;
#pragma unroll
          for (int i = 0; i < 8; ++i) { rf += bff[(sg * 8 + i) * 132 + k]; vf[i] = rf; vb[i] = rb; rb += bfb[(sg * 8 + i) * 132 + k]; }
          seg[sg * 128 + k] = rf; seg[512 + sg * 128 + k] = rb;
          __syncthreads();
          float of = 0.f, ob2 = 0.f;
#pragma unroll
          for (int s2 = 0; s2 < 3; ++s2) { of += (s2 < sg) ? seg[s2 * 128 + k] : 0.f; ob2 += (s2 < sg) ? seg[512 + s2 * 128 + k] : 0.f; }
#pragma unroll
          for (int i = 0; i < 8; ++i) { bff[(sg * 8 + i) * 132 + k] = vf[i] + of; bfb[(sg * 8 + i) * 132 + k] = vb[i] + ob2; }
          if (sg == 3) { btot[k] = rf + of; totb[k] = rb + ob2; } }
        __syncthreads();
        { const int t = tid >> 4, c8 = (tid & 15) * 8;
#pragma unroll
          for (int j = 0; j < 8; ++j) { const int k = c8 + j; const int pi = k * 40 + tphys<4, 3>(k, t);
              kTf[pi] = f2bf1(kff[t * 132 + k] * __expf(btot[k] - bff[t * 132 + k]));
              kTb[pi] = f2bf1(kfb[t * 132 + k] * __expf(fminf(offb[k] + bfb[t * 132 + k], 0.f))); } }
        __syncthreads();
#pragma unroll
        for (int kt = 0; kt < 8; ++kt) { if ((kt & 3) == 0) __builtin_amdgcn_sched_barrier(0); const float e = __expf(btot[kt * 16 + (lane & 15)]);
            const int ra = (w * 16 + (lane & 15)) >> 3, rb2 = (kt * 16 + (lane & 15)) >> 3;
            f32x4 a = sf[kt] * e; a = mma_nt(vT + w * 16 * 40, 40, kTf + kt * 16 * 40, 40, 32, a, lane, ra, rb2); sf[kt] = a;
            sb[kt] = mma_nt(vT + w * 16 * 40, 40, kTb + kt * 16 * 40, 40, 32, sb[kt], lane, ra, rb2); }
        if (tid < 128) { offb[tid] += totb[tid]; fsum[tid] += btot[tid]; }
        __syncthreads();
    }
#pragma unroll
    for (int dir = 0; dir < 2; ++dir) { const int chain = (b * 2 + dir) * 4 + head, scidx = dir ? sc_mirror(c) : c;
        LAS float* stg = (LAS float*)F.lds; LAS float* sp = stg + (w * 16 + (lane >> 4) * 4) * 128 + (lane & 15);
        float dk = 0.f; if (tid < 128) dk = __expf(dir ? offb[tid] : fsum[tid]);
        __syncthreads();
#pragma unroll
        for (int kt = 0; kt < 8; ++kt)
#pragma unroll
            for (int r = 0; r < 4; ++r) sp[r * 128 + kt * 16] = dir ? sb[kt][r] : sf[kt][r];
        __syncthreads();
        copy_l2g(F, stg, WSP(bf16_t, wsmap::ST_HG) + ((size_t)chain * NSC + scidx) * 16384, 16384);
        if (tid < 128) WSP(float, wsmap::DEC_HG)[((size_t)chain * NSC + scidx) * 128 + tid] = dk; }
}
constexpr int M2_SSD = 32 * 4096 / (2 * NTHREADS), M2_ML = 16 * 144 * 128 / (2 * NTHREADS), M2_HG = 16 * 16384 / (2 * NTHREADS);
template <int DECMODE> __device__ __forceinline__ void carry_run(unsigned* p0, size_t pw, const float* dec0) {
    constexpr int CB = 13;
    float run0 = 0.f, run1 = 0.f;
#pragma unroll 1
    for (int cb = 0; cb < NSC; cb += CB) {
        unsigned loc[CB]; float d0[CB], d1[CB];
#pragma unroll
        for (int i = 0; i < CB; ++i) { const int c = cb + i < NSC ? cb + i : NSC - 1; loc[i] = GLD(unsigned, p0 + (size_t)c * pw);
            if (DECMODE) { const f32x2 dd = GLD(f32x2, dec0 + (size_t)c * 128); d0[i] = dd.x; d1[i] = dd.y; } else { d0[i] = d1[i] = GLD(float, dec0 + c); } }
        __builtin_amdgcn_sched_barrier(0);
#pragma unroll
        for (int i = 0; i < CB; ++i) if (cb + i < NSC) { GST(unsigned, p0 + (size_t)(cb + i) * pw) = cvt_pk_bf16(run0, run1); run0 = d0[i] * run0 + bflo(loc[i]); run1 = d1[i] * run1 + bfhi(loc[i]); }
    }
}
__device__ __forceinline__ void carry_item(const Frame& F, int it) {
    bf16_t* st; const float* dec; size_t per; int chain, e; int decmode;
    if (it < M2_SSD) { const int g = (it * NTHREADS + F.tid) * 2; chain = g / 4096; e = g % 4096; st = WSP(bf16_t, wsmap::ST_SSD); dec = WSP(float, wsmap::DEC_SSD); per = 4096; decmode = 0; }
    else if (it < M2_SSD + M2_ML) { const int g = ((it - M2_SSD) * NTHREADS + F.tid) * 2; chain = g / (144 * 128); e = g % (144 * 128); st = WSP(bf16_t, wsmap::ST_ML); dec = WSP(float, wsmap::DEC_ML); per = 144 * 128; decmode = 0; }
    else { const int g = ((it - M2_SSD - M2_ML) * NTHREADS + F.tid) * 2; chain = g / 16384; e = g % 16384; st = WSP(bf16_t, wsmap::ST_HG); dec = WSP(float, wsmap::DEC_HG); per = 16384; decmode = 1; }
    unsigned* p0 = (unsigned*)(st + (size_t)chain * NSC * per + e); const size_t pw = per / 2;
    if (decmode) carry_run<1>(p0, pw, dec + (size_t)chain * NSC * 128 + (e & 127)); else carry_run<0>(p0, pw, dec + (size_t)chain * NSC);
}
__device__ __forceinline__ f32x2 cmul(f32x2 a, f32x2 b) { return a * (f32x2){b.x, b.x} + (f32x2){-a.y, a.x} * (f32x2){b.y, b.y}; }
__device__ __forceinline__ f32x2 cconj(f32x2 a) { return (f32x2){a.x, -a.y}; }
__device__ __forceinline__ f32x2 twid(float f) { return (f32x2){__builtin_amdgcn_cosf(f), -__builtin_amdgcn_sinf(f)}; }
__device__ __forceinline__ f32x2 mul_mi(f32x2 a) { return (f32x2){a.y, -a.x}; }
__device__ __forceinline__ f32x2 mul_pi(f32x2 a) { return (f32x2){-a.y, a.x}; }
__device__ __forceinline__ void dif8(f32x2 (&x)[8], f32x2 w1) {
    const float c = 0.70710678118654752f;
    const f32x2 w2 = cmul(w1, w1), w4 = cmul(w2, w2);
    const f32x2 t1 = (f32x2){c * (w1.x + w1.y), c * (w1.y - w1.x)};
    f32x2 u[4], v[4];
#pragma unroll
    for (int m = 0; m < 4; ++m) { u[m] = x[m] + x[m + 4]; v[m] = x[m] - x[m + 4]; }
    v[0] = cmul(v[0], w1); v[1] = cmul(v[1], t1); v[2] = cmul(mul_mi(v[2]), w1); v[3] = cmul(mul_mi(v[3]), t1);
#pragma unroll
    for (int hf = 0; hf < 2; ++hf) { f32x2* z = hf ? v : u;
        const f32x2 a0 = z[0] + z[2], a1 = z[1] + z[3], b0 = cmul(z[0] - z[2], w2), b1 = cmul(mul_mi(z[1] - z[3]), w2);
        x[hf * 4 + 0] = a0 + a1; x[hf * 4 + 1] = cmul(a0 - a1, w4); x[hf * 4 + 2] = b0 + b1; x[hf * 4 + 3] = cmul(b0 - b1, w4); }
}
__device__ __forceinline__ void dit8(f32x2 (&x)[8], f32x2 w1) {
    const float c = 0.70710678118654752f;
    const f32x2 cw1 = cconj(w1), cw2 = cmul(cw1, cw1), cw4 = cmul(cw2, cw2);
    const f32x2 ct1 = (f32x2){c * (cw1.x - cw1.y), c * (cw1.y + cw1.x)};
    f32x2 u[4], v[4];
#pragma unroll
    for (int hf = 0; hf < 2; ++hf) { f32x2* z = hf ? v : u;
        const f32x2 y1 = cmul(x[hf * 4 + 1], cw4), y3 = cmul(x[hf * 4 + 3], cw4);
        const f32x2 a0 = x[hf * 4 + 0] + y1, a1 = x[hf * 4 + 0] - y1, b0 = x[hf * 4 + 2] + y3, b1 = x[hf * 4 + 2] - y3;
        const f32x2 q0 = cmul(b0, cw2), q1 = mul_pi(cmul(b1, cw2));
        z[0] = a0 + q0; z[2] = a0 - q0; z[1] = a1 + q1; z[3] = a1 - q1; }
    v[0] = cmul(v[0], cw1); v[1] = cmul(v[1], ct1); v[2] = mul_pi(cmul(v[2], cw1)); v[3] = mul_pi(cmul(v[3], ct1));
#pragma unroll
    for (int m = 0; m < 4; ++m) { x[m] = u[m] + v[m]; x[m + 4] = u[m] - v[m]; }
}
__device__ __forceinline__ int zsw(int i) { return i ^ (((i >> 5) & 7) << 2); }
template <int E> __device__ __forceinline__ void fft_addr8(int j, int (&a)[8]) {
    const int p = j & (E - 1), base = ((j - p) << 3) + p;
    if constexpr (E >= 256) { const int b = zsw(base) << 3;
#pragma unroll
        for (int m = 0; m < 8; ++m) a[m] = b + m * E * 8; }
    else if constexpr (E == 32) { const int hi = (base & ~31) << 3;
#pragma unroll
        for (int m = 0; m < 8; ++m) a[m] = hi + m * 256 + ((p ^ (m << 2)) << 3); }
    else if constexpr (E == 4) { const int s = (base >> 5) & 7;
#pragma unroll
        for (int m = 0; m < 8; ++m) a[m] = (base + ((m ^ s) << 2)) << 3; }
    else {
#pragma unroll
        for (int m = 0; m < 8; ++m) a[m] = zsw(base + m * E) << 3; }
}
template <int N, int E, bool INV> __device__ __forceinline__ void fft_pass8(LAS f32x2* Z, int tid) {
    const float inv = 1.0f / (float)(8 * E);
    int t0 = tid;
#ifndef CPU_EMU
    asm volatile("" : "+v"(t0));
#endif
#pragma unroll 2
    for (int j = t0; j < N / 8; j += NTHREADS) { int a[8]; fft_addr8<E>(j, a);
        f32x2 x[8];
#pragma unroll
        for (int m = 0; m < 8; ++m) x[m] = *(const LAS f32x2*)((const LAS unsigned char*)Z + a[m]);
        if constexpr (INV) dit8(x, twid((float)(j & (E - 1)) * inv)); else dif8(x, twid((float)(j & (E - 1)) * inv));
#pragma unroll
        for (int m = 0; m < 8; ++m) *(LAS f32x2*)((LAS unsigned char*)Z + a[m]) = x[m]; }
    __syncthreads();
}
template <int N, int H> __device__ __forceinline__ void fft_dif_rec(LAS f32x2* Z, int tid) {
    if constexpr (H >= 4) { fft_pass8<N, H / 4, false>(Z, tid); fft_dif_rec<N, H / 8>(Z, tid); }
    else if constexpr (H == 2) {
        for (int j = tid; j < N / 4; j += NTHREADS) { const int ia = zsw(j << 2);
            const f32x2 a = Z[ia], b = Z[ia + 1], c = Z[ia + 2], d = Z[ia + 3];
            const f32x2 a1 = a + c, c1 = a - c, b1 = b + d, d1 = mul_mi(b - d);
            Z[ia] = a1 + b1; Z[ia + 1] = a1 - b1; Z[ia + 2] = c1 + d1; Z[ia + 3] = c1 - d1; }
        __syncthreads(); }
    else if constexpr (H == 1) {
        for (int j = tid; j < N / 2; j += NTHREADS) { const int i2 = zsw(2 * j); const f32x2 a = Z[i2], b = Z[i2 + 1]; Z[i2] = a + b; Z[i2 + 1] = a - b; }
        __syncthreads(); }
}
template <int N> __device__ __forceinline__ void fft_dif(LAS f32x2* Z, int tid) { fft_dif_rec<N, N / 2>(Z, tid); }
template <int N, int E> __device__ __forceinline__ void fft_dit_rec(LAS f32x2* Z, int tid) {
    if constexpr (E <= N / 8) { fft_pass8<N, E, true>(Z, tid); fft_dit_rec<N, E * 8>(Z, tid); }
}
template <int N> __device__ __forceinline__ void fft_dit_inv(LAS f32x2* Z, int tid) {
    constexpr int lg = __builtin_ctz((unsigned)N);
    if constexpr (lg % 3 == 2) {
        for (int j = tid; j < N / 4; j += NTHREADS) { const int ia = zsw(j << 2);
            const f32x2 a = Z[ia], b = Z[ia + 1], c = Z[ia + 2], d = Z[ia + 3];
            const f32x2 a1 = a + b, b1 = a - b, c1 = c + d, d1 = mul_pi(c - d);
            Z[ia] = a1 + c1; Z[ia + 2] = a1 - c1; Z[ia + 1] = b1 + d1; Z[ia + 3] = b1 - d1; }
        __syncthreads(); fft_dit_rec<N, 4>(Z, tid); }
    else if constexpr (lg % 3 == 1) {
        for (int j = tid; j < N / 2; j += NTHREADS) { const int i2 = zsw(2 * j); const f32x2 a = Z[i2], b = Z[i2 + 1]; Z[i2] = a + b; Z[i2 + 1] = a - b; }
        __syncthreads(); fft_dit_rec<N, 2>(Z, tid); }
    else fft_dit_rec<N, 1>(Z, tid);
}
template <int N> __device__ __forceinline__ int brev_n(int k) { int lg = 0; for (int t = N; t > 1; t >>= 1) ++lg; return (int)(__brev((unsigned)k) >> (32 - lg)); }
template <int N, int MODE> __device__ __forceinline__ void spectrum_step(LAS f32x2* Z, f32x2* Hs, int tid, float scale) {
    if (tid == 0) {
        const f32x2 z = Z[0], zh = Z[1];
        if (MODE == 0) { GST(f32x2, Hs) = (f32x2){(z.x + z.y) * scale, 0.f}; GST(f32x2, Hs + N) = (f32x2){(z.x - z.y) * scale, 0.f}; GST(f32x2, Hs + 1) = cconj(zh) * scale; }
        else { const float y0 = (z.x + z.y) * GLD(f32x2, Hs).x, yn = (z.x - z.y) * GLD(f32x2, Hs + N).x; Z[0] = (f32x2){0.5f * (y0 + yn), 0.5f * (y0 - yn)}; Z[1] = cconj(cmul(cconj(zh), GLD(f32x2, Hs + 1))); } }
    if constexpr (MODE == 0) {
#pragma unroll 4
        for (int s = tid == 0 ? NTHREADS : tid; s < N / 2; s += NTHREADS) {
            const int pk = 2 * s, k = brev_n<N>(pk);
            const int pn = brev_n<N>(N - k);
            const int qk = zsw(pk), qn = zsw(pn);
            const f32x2 zk = Z[qk], zn = cconj(Z[qn]), wk = twid((float)k * (0.5f / (float)N));
            const f32x2 E = (zk + zn) * 0.5f, dd = (zk - zn) * 0.5f, O = (f32x2){dd.y, -dd.x};
            const f32x2 wo = cmul(wk, O), Xk = E + wo, Xn = cconj(E - wo);
            GST(f32x2, Hs + pk) = Xk * scale; GST(f32x2, Hs + pn) = Xn * scale;
        }
    } else {
        constexpr int U = 4;
#pragma unroll 1
        for (int s0 = tid; s0 < N / 2; s0 += U * NTHREADS) {
            f32x2 hk[U], hn[U]; int pk[U], pn[U]; bool ok[U];
#pragma unroll
            for (int u = 0; u < U; ++u) { const int s = s0 + u * NTHREADS; ok[u] = s > 0 && s < N / 2; pk[u] = ok[u] ? 2 * s : 2; pn[u] = brev_n<N>(N - brev_n<N>(pk[u]));
                hk[u] = GLD(f32x2, Hs + pk[u]); hn[u] = GLD(f32x2, Hs + pn[u]); }
            __builtin_amdgcn_sched_barrier(0);
#pragma unroll
            for (int u = 0; u < U; ++u) { const int k = brev_n<N>(pk[u]); const int qk = zsw(pk[u]), qn = zsw(pn[u]);
                const f32x2 zk = Z[qk], zn = cconj(Z[qn]), wk = twid((float)k * (0.5f / (float)N));
                const f32x2 E = (zk + zn) * 0.5f, dd = (zk - zn) * 0.5f, O = (f32x2){dd.y, -dd.x};
                const f32x2 wo = cmul(wk, O), Xk = E + wo, Xn = cconj(E - wo);
                const f32x2 Yk = cmul(Xk, hk[u]), Yn = cconj(cmul(Xn, hn[u]));
                const f32x2 Ye = (Yk + Yn) * 0.5f, Yo = cmul((Yk - Yn) * 0.5f, cconj(wk));
                if (ok[u]) { Z[qk] = (f32x2){Ye.x - Yo.y, Ye.y + Yo.x};
                             Z[qn] = (f32x2){Ye.x + Yo.y, -Ye.y + Yo.x}; } }
        }
    }
    __syncthreads();
}
template <int N> __device__ __forceinline__ void hy_conv8(const bf16_t* hrow, int t0, float w0, float w1, float w2, float bias, float (&o)[8]) {
    float x[8]; unpack8(GLD(u32x4, hrow + t0), x);
    const float xm = t0 > 0 ? bf2f(GLD(bf16_t, hrow + t0 - 1)) : 0.f, xp = t0 + 8 < N ? bf2f(GLD(bf16_t, hrow + t0 + 8)) : 0.f;
#pragma unroll
    for (int j = 0; j < 8; ++j) o[j] = w0 * (j ? x[j - 1] : xm) + w1 * x[j] + w2 * (j < 7 ? x[j + 1] : xp) + bias;
}
struct HyRaw { u32x4 x; unsigned short xm, xp; };
template <int N> __device__ __forceinline__ HyRaw hy_load8(const bf16_t* hrow, int t0) {
    HyRaw r; r.x = GLD(u32x4, hrow + t0); r.xm = GLD(bf16_t, hrow + (t0 > 0 ? t0 - 1 : 0)); r.xp = GLD(bf16_t, hrow + (t0 + 8 < N ? t0 + 8 : t0)); return r; }
template <int N> __device__ __forceinline__ void hy_conv8_raw(const HyRaw& r, int t0, float w0, float w1, float w2, float bias, float (&o)[8]) {
    float x[8]; unpack8(r.x, x);
    const float xm = t0 > 0 ? bf2f(r.xm) : 0.f, xp = t0 + 8 < N ? bf2f(r.xp) : 0.f;
#pragma unroll
    for (int j = 0; j < 8; ++j) o[j] = w0 * (j ? x[j - 1] : xm) + w1 * x[j] + w2 * (j < 7 ? x[j + 1] : xp) + bias;
}
template <int N> __device__ __forceinline__ void hyena_channel(const Frame& F, int l, int c, bool is_ctx) {
    LAS f32x2* Z = (LAS f32x2*)F.lds; LAS float* Zf = (LAS float*)F.lds;
    LAS float* red = (LAS float*)(F.lds + (size_t)N * 8);
    const int tid = F.tid;
    unsigned char* scr = F.ws + wsmap::WSCR + (size_t)F.bid * wsmap::WSCR_PER;
    f32x2* Hs0 = (f32x2*)(scr + wsmap::WSCR_H); f32x2* Hs1 = (f32x2*)(scr + wsmap::WSCR_H1); bf16_t* z1 = (bf16_t*)(scr + wsmap::WSCR_Z1);
    float* G1 = (float*)Hs1;
    const float* cw = inp(F, I_HY_CW) + (size_t)l * 3 * HYC; const float* cb = inp(F, I_HY_CB) + (size_t)l * HYC;
    const float* w3 = inp(F, I_HY_W3) + (size_t)l * 64 * 2048;
    const float la = -3.0701134573253946f, lbb = -15.350567286626973f;
    const float delta = fabsf(la + (lbb - la) * ((float)c / 511.0f));
    const bf16_t* hyt = WSP(bf16_t, wsmap::HYT);
    __syncthreads();
    if (tid == 0) { Zf[2 * zsw(N >> 1)] = 0.f; G1[N] = 0.f; }
    float as0 = 0.f, as1 = 0.f;
    { const bf16_t* hidp = WSP(bf16_t, wsmap::HID) + ((size_t)l * LSEQ + (is_ctx ? SEQ : 0)) * 64;
      const int lane = F.lane, col = lane & 15, kg = lane >> 4; const float dscale = delta / (float)(N > 1 ? N - 1 : 1);
      bf16x8 bfr[2];
#pragma unroll
      for (int kk = 0; kk < 2; ++kk)
#pragma unroll
          for (int j = 0; j < 8; ++j) bfr[kk][j] = (short)f2bf1(w3[(size_t)(kk * 32 + kg * 8 + j) * 2048 + (col & 3) * 512 + c]);
      constexpr int US = 8;
      const int q = col >> 2, tp = col & 3; const bool bwd = tp & 1;
#pragma unroll 1
      for (int db = F.wave * 16; db < N; db += 128 * US) {
          bf16x8 a0[US], a1[US];
#pragma unroll
          for (int u = 0; u < US; ++u) { const int d0 = db + u * 128; const bf16_t* ap = hidp + (size_t)((d0 < N ? d0 : db) + col) * 64 + kg * 8;
              a0[u] = GLD(bf16x8, ap); a1[u] = GLD(bf16x8, ap + 32); }
          __builtin_amdgcn_sched_barrier(0);
#pragma unroll
          for (int u = 0; u < US; ++u) { const int d0 = db + u * 128;
              f32x4 a = (f32x4){0.f, 0.f, 0.f, 0.f};
              a = __builtin_amdgcn_mfma_f32_16x16x32_bf16(a0[u], bfr[0], a, 0, 0, 0);
              a = __builtin_amdgcn_mfma_f32_16x16x32_bf16(a1[u], bfr[1], a, 0, 0, 0);
              const int d = d0 + kg * 4 + q;
              const float aq = q == 0 ? a[0] : q == 1 ? a[1] : q == 2 ? a[2] : a[3];
              const float v = aq * __expf(-(float)d * dscale);
              const int j = bwd ? 2 * N - d : d;
              if (d0 < N && (!bwd || d > 0)) { if (tp < 2) { Zf[2 * zsw(j >> 1) + (j & 1)] = v; as0 += fabsf(v); } else { GST(float, G1 + j) = v; as1 += fabsf(v); } } } } }
    as0 = wave_sum(as0); as1 = wave_sum(as1);
    if (F.lane == 0) { red[F.wave] = as0; red[8 + F.wave] = as1; }
    __syncthreads();
    float inv0 = 0.f, inv1 = 0.f;
#pragma unroll
    for (int q = 0; q < 8; ++q) { inv0 += red[q]; inv1 += red[8 + q]; }
    inv0 = 1.0f / (inv0 + 1e-6f); inv1 = 1.0f / (inv1 + 1e-6f);
    fft_dif<N>(Z, tid);
    spectrum_step<N, 0>(Z, Hs0, tid, inv0);
#pragma unroll 4
    for (int j = tid * 4; j < 2 * N; j += NTHREADS * 4) *(LAS f32x4*)(Zf + 2 * zsw(j >> 1)) = GLD(f32x4, G1 + j);
    __syncthreads();
    fft_dif<N>(Z, tid);
    spectrum_step<N, 0>(Z, Hs1, tid, inv1);
    const float vw0 = cw[c], vw1 = cw[HYC + c], vw2 = cw[2 * HYC + c], vb = cb[c];
#pragma unroll 1
    for (int o = 0; o < 2; ++o) {
        const int xp = o + 1;
        f32x2* Hs = o ? Hs1 : Hs0;
        const float skip = inp(F, I_HY_SKIP)[((size_t)l * 2 + o) * 512 + c];
        const float xw0 = cw[xp * 512 + c], xw1 = cw[HYC + xp * 512 + c], xw2 = cw[2 * HYC + xp * 512 + c], xb = cb[xp * 512 + c];
#pragma unroll 1
        for (int b = 0; b < NB; ++b) {
            const int r0 = is_ctx ? NLAT + b * CTXL : b * SEQ;
            const bf16_t* vrow = hyt + (size_t)c * MROWS + r0; const bf16_t* xrow = hyt + (size_t)(xp * 512 + c) * MROWS + r0;
            bf16_t* z1b = z1 + (size_t)b * N;
            constexpr int UI = 4;
#pragma unroll 1
            for (int tb = tid * 8; tb < N; tb += UI * NTHREADS * 8) {
                HyRaw rv[UI]; u32x4 rz[UI];
#pragma unroll
                for (int i = 0; i < UI; ++i) { const int t0 = tb + i * NTHREADS * 8; const int tc = t0 < N ? t0 : tb;
                    if (o == 0) rv[i] = hy_load8<N>(vrow, tc); else rz[i] = GLD(u32x4, z1b + tc); }
                __builtin_amdgcn_sched_barrier(0);
#pragma unroll
                for (int i = 0; i < UI; ++i) { const int t0 = tb + i * NTHREADS * 8; float u[8];
                    if (t0 < N) { if (o == 0) hy_conv8_raw<N>(rv[i], t0, vw0, vw1, vw2, vb, u); else unpack8(rz[i], u);
                        LAS float* zp = Zf + 2 * zsw(t0 >> 1);
                        *(LAS f32x4*)(zp) = (f32x4){u[0], u[1], u[2], u[3]}; *(LAS f32x4*)(zp + 4) = (f32x4){u[4], u[5], u[6], u[7]}; } } }
#pragma unroll 4
            for (int t0 = N + tid * 8; t0 < 2 * N; t0 += NTHREADS * 8) { LAS float* zp = Zf + 2 * zsw(t0 >> 1);
                *(LAS f32x4*)(zp) = (f32x4){0.f, 0.f, 0.f, 0.f}; *(LAS f32x4*)(zp + 4) = (f32x4){0.f, 0.f, 0.f, 0.f}; }
            __syncthreads();
#ifdef PROBE_FFT
            fft_dif<N>(Z, tid); fft_dit_inv<N>(Z, tid);
            for (int j = tid; j < N; j += NTHREADS) Z[j] = Z[j] * (1.0f / (float)N);
            __syncthreads();
#endif
            fft_dif<N>(Z, tid);
            spectrum_step<N, 1>(Z, Hs, tid, 1.0f);
            fft_dit_inv<N>(Z, tid);
            const float sn = 1.0f / (float)N;
#pragma unroll 1
            for (int tb = tid * 8; tb < N; tb += UI * NTHREADS * 8) {
                HyRaw rv[UI], rx[UI]; u32x4 rz[UI];
#pragma unroll
                for (int i = 0; i < UI; ++i) { const int t0 = tb + i * NTHREADS * 8; const int tc = t0 < N ? t0 : tb;
                    if (o == 0) rv[i] = hy_load8<N>(vrow, tc); else rz[i] = GLD(u32x4, z1b + tc);
                    rx[i] = hy_load8<N>(xrow, tc); }
                __builtin_amdgcn_sched_barrier(0);
#pragma unroll
                for (int i = 0; i < UI; ++i) { const int t0 = tb + i * NTHREADS * 8; float u[8], xv[8], zo[8];
                    if (t0 < N) {
                        if (o == 0) hy_conv8_raw<N>(rv[i], t0, vw0, vw1, vw2, vb, u); else unpack8(rz[i], u);
                        hy_conv8_raw<N>(rx[i], t0, xw0, xw1, xw2, xb, xv);
                        const LAS float* zp = Zf + 2 * zsw(t0 >> 1);
                        const f32x4 y0 = *(const LAS f32x4*)(zp), y1 = *(const LAS f32x4*)(zp + 4);
#pragma unroll
                        for (int j = 0; j < 8; ++j) zo[j] = xv[j] * ((j < 4 ? y0[j] : y1[j - 4]) * sn + u[j] * skip);
                        u32x4 w; w.x = cvt_pk_bf16(zo[0], zo[1]); w.y = cvt_pk_bf16(zo[2], zo[3]); w.z = cvt_pk_bf16(zo[4], zo[5]); w.w = cvt_pk_bf16(zo[6], zo[7]);
                        if (o == 0) GST(u32x4, z1b + t0) = w; else GST(u32x4, WSP(bf16_t, wsmap::YBT) + (size_t)c * MROWS + r0 + t0) = w; } } }
            __syncthreads();
        }
    }
}
constexpr int HYTR_ITEMS = (512 / 64) * (MROWS / 64);
__device__ __forceinline__ void hyena_transpose_item(const Frame& F, int it) {
    LAS bf16_t* tile = (LAS bf16_t*)F.lds;
    const int cb = it % 8, rb = it / 8, tid = F.tid;
    __syncthreads();
    { const int ch = tid >> 3, r8 = (tid & 7) * 8; const u32x4 v = *(const u32x4*)(WSP(bf16_t, wsmap::YBT) + (size_t)(cb * 64 + ch) * MROWS + rb * 64 + r8);
      const unsigned vw[4] = {v.x, v.y, v.z, v.w};
#pragma unroll
      for (int j = 0; j < 8; ++j) tile[ch * 66 + r8 + j] = (bf16_t)((vw[j >> 1] >> ((j & 1) * 16)) & 0xFFFFu); }
    __syncthreads();
    { const int r = tid >> 3, c8 = (tid & 7) * 8; unsigned w[4];
#pragma unroll
      for (int j = 0; j < 4; ++j) w[j] = (unsigned)tile[(c8 + 2 * j) * 66 + r] | ((unsigned)tile[(c8 + 2 * j + 1) * 66 + r] << 16);
      GST(u32x4, WSP(bf16_t, wsmap::HYB) + (size_t)(rb * 64 + r) * HY_LD + 1024 + 512 + cb * 64 + c8) = (u32x4){w[0], w[1], w[2], w[3]}; }
}

__device__ __forceinline__ Frame phase_frame(const Frame& F) {
    Frame R = F; R.tid = F.wave * 64 + lane_id();
#ifndef CPU_EMU
    asm volatile("" : "+v"(R.tid)); asm volatile("" : "+s"(R.bid)); asm volatile("" : "+s"(R.G)); asm volatile("" : "+s"(R.ws));
#endif
    R.ws = (unsigned char*)(GAS unsigned char*)R.ws;
    R.lane = R.tid & 63; R.wave = __builtin_amdgcn_readfirstlane(R.tid >> 6); return R;
}
__device__ __forceinline__ int opaque_s(int v) {
#ifndef CPU_EMU
    asm volatile("" : "+s"(v));
#endif
    return v;
}
constexpr int PH_PER_LAYER = 12, NPHASES = 1 + DEPTH * PH_PER_LAYER + 1;
template <int SEL = 15, int QOFF = 0> __device__ __forceinline__ void phase_mix1(const Frame& F, int l) {
    const int n_hy = (l < DEPTH - 1) ? 1024 : 512, n_hg = 8 * NSC, n_ml = 8 * NSC, n_sd = 16 * NSC, qb = l * 8 + QOFF;
    if constexpr (SEL & 1) { int nx = 0; q_issue(F, qb + 0, nx); for (;;) { const Frame Fh = phase_frame(F); const int it = q_take(Fh, nx); if (it >= n_hy) break; q_issue(Fh, qb + 0, nx); if (it < 512) hyena_channel<SEQ>(Fh, l, it, false); else { hyena_channel<CTXL>(Fh, l, it - 512, true);
#ifdef PROBE_CTX2
        hyena_channel<CTXL>(Fh, l, it - 512, true);
#endif
    } } }
    if constexpr (SEL & 2) { int nx = 0; q_issue(F, qb + 1, nx); for (;;) { const Frame Fh = phase_frame(F); const int it = q_take(Fh, nx); if (it >= n_hg) break; q_issue(Fh, qb + 1, nx); hg_m1f_item(Fh, l, it); } }
    if constexpr (SEL & 4) { int nx = 0; q_issue(F, qb + 2, nx); for (;;) { const Frame Fh = phase_frame(F); const int it = q_take(Fh, nx); if (it >= n_ml) break; q_issue(Fh, qb + 2, nx); ml_m1f_item(Fh, l, it); } }
    if constexpr (SEL & 8) for (;;) { const Frame Fh = phase_frame(F); const int it = q_pull(Fh, qb + 3); if (it >= n_sd) break; sd_m1f_item(Fh, l, it); }
}
__device__ __forceinline__ void phase_mix2(const Frame& F, int l) {
    const int n_c = M2_SSD + M2_ML + M2_HG;
    for (int it = F.bid; it < n_c + HYTR_ITEMS; it += F.G) { if (it < n_c) carry_item(F, it); else hyena_transpose_item(F, it - n_c); }
}
template <int SEL = 15, int QOFF = 0> __device__ __forceinline__ void phase_mix3(const Frame& F, int l) {
    const int c0 = (l < DEPTH - 1) ? 0 : NSC_C, nc = NSC - c0;
    const int n_hg = 8 * nc, n_ml = 8 * nc, n_sd = 16 * nc, qb = l * 8 + 4 + QOFF;
    if constexpr (SEL & 2) { int nx = 0; q_issue(F, qb + 0, nx); for (;;) { const Frame Fh = phase_frame(F); const int it = q_take(Fh, nx); if (it >= n_hg) break; q_issue(Fh, qb + 0, nx); hg_m3_item(Fh, l, (it / nc) * NSC + c0 + it % nc); } }
    if constexpr (SEL & 4) { int nx = 0; q_issue(F, qb + 1, nx); for (;;) { const Frame Fh = phase_frame(F); const int it = q_take(Fh, nx); if (it >= n_ml) break; q_issue(Fh, qb + 1, nx); ml_m3_item(Fh, l, (it / nc) * NSC + c0 + it % nc); } }
    if constexpr (SEL & 8) for (;;) { const Frame Fh = phase_frame(F); const int it = q_pull(Fh, qb + 2); if (it >= n_sd) break; sd_m3_item(Fh, l, (it / nc) * NSC + c0 + it % nc); }
}
__device__ __forceinline__ void phase_k0(const Frame& F, int l) {
    phase_norm1(F, l);
}

#ifdef CPU_EMU
#define DYN_LDS_DECL unsigned char* shm = emu::dyn_lds();
#else
#define DYN_LDS_DECL extern __shared__ __attribute__((aligned(16))) unsigned char shm[];
#endif

#ifdef CPU_EMU
#define MEGA_TARGET
#else
#define MEGA_TARGET __attribute__((target("no-packed-fp32-ops")))
#endif
__global__ void __launch_bounds__(512, 2) MEGA_TARGET mega(Params p) {
    DYN_LDS_DECL
    Frame F; F.lds = (LAS unsigned char*)shm; F.tid = threadIdx.x; F.lane = F.tid & 63; F.wave = __builtin_amdgcn_readfirstlane(F.tid >> 6);
    F.G = gridDim.x; F.bid = blockIdx.x; F.ws = p.ws; F.p = &p;
    if (F.tid < 38) *(LAS unsigned long long*)(F.lds + PTR_OFF + F.tid * 8) = (unsigned long long)p.in[F.tid];
    __syncthreads();
    volatile LAS unsigned* xbw = (volatile LAS unsigned*)(F.lds + LDS_BYTES - 16);
    const int lo = p.ph_lo, hi = p.ph_hi;
    XcdBarrier bar; bar.bar = (unsigned*)(F.ws + wsmap::CTL); bar.x = 0; bar.st = xbw;
    if (hi - lo > 1) { if (F.tid == 0) { xbw[0] = 0u; xbw[1] = 0u; } __syncthreads(); bar = xcd_barrier_post((unsigned*)(F.ws + wsmap::CTL), xbw, F.tid == 0); }
#ifndef REPEAT_PH
#define REPEAT_PH 0
#endif
#ifndef REPEAT_SEL
#define REPEAT_SEL 15
#endif
#define RP(b, call) do { call; if constexpr ((REPEAT_PH >> (b)) & 1) { __syncthreads(); call; } } while (0)
#define IN(k) (lo <= (k) && (k) < hi)
#define SEAM(k) do { if (IN(k) && IN((k) + 1)) xcd_barrier(bar, F.wave == 0 && lane_id() == 0); } while (0)
    if (IN(0)) RP(0, phase_a0(phase_frame(F)));
    SEAM(0);
#pragma unroll 1
    for (int l0 = 0; l0 < DEPTH; ++l0) { const int pb = 1 + l0 * PH_PER_LAYER;
        if (IN(pb + 0)) phase_k0(phase_frame(F), opaque_s(l0));
        SEAM(pb + 0);
        if (IN(pb + 1)) RP(2, phase_proj(phase_frame(F)));
        SEAM(pb + 1);
        if (IN(pb + 2)) { phase_mix1(phase_frame(F), opaque_s(l0)); if constexpr ((REPEAT_PH >> 3) & 1) { __syncthreads(); phase_mix1<REPEAT_SEL, 16>(phase_frame(F), opaque_s(l0)); } }
        SEAM(pb + 2);
        if (IN(pb + 3)) phase_mix2(phase_frame(F), opaque_s(l0));
        SEAM(pb + 3);
        if (IN(pb + 4)) { phase_mix3(phase_frame(F), opaque_s(l0)); if constexpr ((REPEAT_PH >> 5) & 1) { __syncthreads(); phase_mix3<REPEAT_SEL, 16>(phase_frame(F), opaque_s(l0)); } }
        SEAM(pb + 4);
        if (IN(pb + 5)) RP(6, phase_gate_branch(phase_frame(F), opaque_s(l0)));
        SEAM(pb + 5);
        if (IN(pb + 6)) phase_outproj(phase_frame(F), opaque_s(l0));
        SEAM(pb + 6);
        if (IN(pb + 7)) RP(8, phase_norm2_router(phase_frame(F), opaque_s(l0)));
        SEAM(pb + 7);
        if (IN(pb + 8)) RP(9, phase_topk(phase_frame(F), opaque_s(l0)));
        SEAM(pb + 8);
        if (IN(pb + 9)) RP(10, phase_gather(phase_frame(F), opaque_s(l0)));
        SEAM(pb + 9);
        if (IN(pb + 10)) RP(11, phase_moe_up(phase_frame(F), opaque_s(l0)));
        SEAM(pb + 10);
        if (IN(pb + 11)) RP(12, phase_moe_down(phase_frame(F), opaque_s(l0)));
        SEAM(pb + 11);
    }
    if (IN(NPHASES - 1)) phase_final(phase_frame(F));
#undef IN
#undef SEAM
}

#ifndef CPU_EMU
extern "C" void kernel_launch(void* const* d_in, const int* in_sizes, int n_in, void* d_out, int out_size, void* d_ws, size_t ws_size, hipStream_t stream) {
    static int grid = 0;
    if (grid == 0) {
        if (n_in != 38 || out_size != NLAT * D || ws_size < wsmap::END) { fprintf(stderr, "kernel_launch: unexpected shapes (n_in %d, out %d, ws %zu < %zu)\n", n_in, out_size, ws_size, (size_t)wsmap::END); grid = -1; return; }
        if (hipFuncSetAttribute((const void*)mega, hipFuncAttributeMaxDynamicSharedMemorySize, LDS_BYTES) != hipSuccess) { fprintf(stderr, "kernel_launch: hipFuncSetAttribute failed\n"); grid = -1; return; }
        int dev = 0, cus = 0; hipGetDevice(&dev); hipDeviceGetAttribute(&cus, hipDeviceAttributeMultiprocessorCount, dev);
        grid = cus > 0 ? cus : 256;
    }
    if (grid < 0) return;
    hipMemsetAsync((char*)d_ws + wsmap::CTL, 0, wsmap::CTL_BYTES, stream);
    Params p{};
    for (int i = 0; i < 38; ++i) p.in[i] = (const float*)d_in[i];
    p.out = (float*)d_out; p.ws = (unsigned char*)d_ws;
#if MK_PER_PHASE
    for (int ph = 0; ph < NPHASES; ++ph) { p.ph_lo = ph; p.ph_hi = ph + 1; hipLaunchKernelGGL(mega, dim3(grid), dim3(NTHREADS), LDS_BYTES, stream, p); }
#else
    p.ph_lo = 0; p.ph_hi = NPHASES; hipLaunchKernelGGL(mega, dim3(grid), dim3(NTHREADS), LDS_BYTES, stream, p);
#endif
}
#endif
```

```cpp
#ifndef CPU_EMU
#include <hip/hip_runtime.h>
#endif
#include <stdint.h>
#include <stddef.h>
#include <math.h>
#include <stdio.h>

#ifndef CFG_SEQ
#define CFG_SEQ 16384
#endif
#ifndef CFG_CTX
#define CFG_CTX 256
#endif
#ifndef MK_PER_PHASE
#define MK_PER_PHASE 0
#endif
namespace cfg {
constexpr int SEQ = CFG_SEQ, CTXL = CFG_CTX, NB = 2, D = 1024, DEPTH = 2;
constexpr int NLAT = NB * SEQ, NCTX = NB * CTXL, MROWS = NLAT + NCTX;
constexpr int MT = MROWS / 256, MT_LAT = NLAT / 256;
constexpr int SC = (CTXL >= 256 ? 256 : 128);
constexpr int LSEQ = CTXL + SEQ, NSC = LSEQ / SC;
constexpr int GRID_W = 64, GROWS = SEQ / GRID_W;
constexpr int BW = 512;
constexpr int NE = 16, DE = 2048;
constexpr int CAP_LAT = 2 * SEQ / NE, CAP_CTX = 2 * CTXL / NE;
constexpr int GP_LAT = (CAP_LAT + 255) / 256 * 256, GP_CTX = (CAP_CTX + 255) / 256 * 256;
constexpr int NPAIR_LAT = NB * NE * GP_LAT, NPAIR = NPAIR_LAT + NB * NE * GP_CTX;
constexpr int PC_SSD_Z = 0, PC_SSD_X = 512, PC_SSD_B = 1024, PC_SSD_C = 1152;
constexpr int PC_ML_Q = 1280, PC_ML_K = 1792, PC_ML_V = 2304, PC_ML_O = 2816;
constexpr int PC_HG_Q = 3328, PC_HG_I = 3840, PC_HG_FF = 4352, PC_HG_FB = 4864, PC_HG_G = 5376;
constexpr int PCOLS = 5888, PN1 = 6144;
constexpr int HYC = 1536;
constexpr int HY_LD = 3072;
constexpr int GB_LD = 1536;
constexpr int WIN_COLS = 11552;
constexpr int NTHREADS = 512;
constexpr int LDS_BYTES = 147456;
}
using namespace cfg;

#ifdef CPU_EMU
#define LAS
#define GAS
#define ASM_VMCNT0()
#define ASM_VMCNT4()
#define ASM_VMCNT6()
#define ASM_LGKM0()
#define ASM_LGKM8()
#define ASM_CLOBBER()
#define WAVE_LDS_SYNC() emu::wave_sync()
#else
#define LAS __attribute__((address_space(3)))
#define GAS __attribute__((address_space(1)))
#define ASM_VMCNT0() asm volatile("s_waitcnt vmcnt(0)" ::: "memory")
#define ASM_VMCNT4() asm volatile("s_waitcnt vmcnt(4)" ::: "memory")
#define ASM_VMCNT6() asm volatile("s_waitcnt vmcnt(6)" ::: "memory")
#define ASM_LGKM0() asm volatile("s_waitcnt lgkmcnt(0)" ::: "memory")
#define ASM_LGKM8() asm volatile("s_waitcnt lgkmcnt(8)" ::: "memory")
#define ASM_CLOBBER() asm volatile("" ::: "memory")
#define WAVE_LDS_SYNC() __builtin_amdgcn_wave_barrier()
#endif

typedef unsigned short bf16_t;
typedef short bf16x8 __attribute__((ext_vector_type(8)));
typedef float f32x4 __attribute__((ext_vector_type(4)));
typedef float f32x2 __attribute__((ext_vector_type(2)));
typedef unsigned u32x4 __attribute__((ext_vector_type(4)));
typedef unsigned u32x2 __attribute__((ext_vector_type(2)));
#define GLD(T, p) (*(const GAS T*)(p))
#define GST(T, p) (*(GAS T*)(p))

__device__ __forceinline__ unsigned f2bf_bits(float f) { unsigned u = __float_as_uint(f); u += 0x7FFFu + ((u >> 16) & 1u); return u >> 16; }
__device__ __forceinline__ float bf2f(unsigned short b) { return __uint_as_float(((unsigned)b) << 16); }
__device__ __forceinline__ unsigned cvt_pk_bf16(float lo, float hi) {
#ifdef CPU_EMU
    return f2bf_bits(lo) | (f2bf_bits(hi) << 16);
#else
    typedef __bf16 bf16v2_ __attribute__((ext_vector_type(2)));
    const f32x2 v = {lo, hi}; const bf16v2_ b = __builtin_convertvector(v, bf16v2_); return __builtin_bit_cast(unsigned, b);
#endif
}
__device__ __forceinline__ bf16_t f2bf1(float x) {
#ifdef CPU_EMU
    return (bf16_t)f2bf_bits(x);
#else
    const __bf16 b = (__bf16)x; return __builtin_bit_cast(unsigned short, b);
#endif
}
__device__ __forceinline__ float bflo(unsigned w) { return __uint_as_float(w << 16); }
__device__ __forceinline__ float bfhi(unsigned w) { return __uint_as_float(w & 0xFFFF0000u); }
__device__ __forceinline__ float sigmoidf_(float x) { return __builtin_amdgcn_rcpf(1.0f + __expf(-x)); }
__device__ __forceinline__ float siluf_(float x) { return x * __builtin_amdgcn_rcpf(1.0f + __expf(-x)); }
__device__ __forceinline__ float softplusf_(float x) { return fmaxf(x, 0.f) + __logf(1.0f + __expf(-fabsf(x))); }
__device__ __forceinline__ float logsigmoidf_(float x) { return -softplusf_(-x); }
__device__ __forceinline__ int lane_id() { return (int)__builtin_amdgcn_mbcnt_hi(~0u, __builtin_amdgcn_mbcnt_lo(~0u, 0u)); }
__device__ __forceinline__ float wave_scan_incl(float x) {
#ifdef CPU_EMU
    const int ln = (int)(threadIdx.x & 63);
    for (int d = 1; d < 64; d <<= 1) { const float y = __shfl_up(x, d); if (ln >= d) x += y; }
    return x;
#else
#define WS_DPP_ADD(ctrl, rowmask) x += __builtin_bit_cast(float, __builtin_amdgcn_update_dpp(0, __builtin_bit_cast(int, x), ctrl, rowmask, 0xf, false))
    WS_DPP_ADD(0x111, 0xf); WS_DPP_ADD(0x112, 0xf); WS_DPP_ADD(0x114, 0xf); WS_DPP_ADD(0x118, 0xf); WS_DPP_ADD(0x142, 0xa); WS_DPP_ADD(0x143, 0xc);
#undef WS_DPP_ADD
    return x;
#endif
}
__device__ __forceinline__ float wave_sum(float v) {
#ifdef CPU_EMU
#pragma unroll
    for (int m = 32; m >= 1; m >>= 1) v += __shfl_xor(v, m);
    return v;
#else
    return __builtin_bit_cast(float, __builtin_amdgcn_readlane(__builtin_bit_cast(int, wave_scan_incl(v)), 63));
#endif
}

namespace wsmap {
constexpr size_t al(size_t x) { return (x + 4095) & ~(size_t)4095; }
constexpr size_t CTL = 0;
constexpr size_t CTL_BYTES = 65536;
constexpr size_t MOD = CTL + CTL_BYTES;
constexpr size_t LB = al(MOD + (size_t)DEPTH * 3 * 6144 * 4);
constexpr size_t TWL = al(LB + DEPTH * 512 * 4);
constexpr size_t TWC = al(TWL + (size_t)SEQ * 8);
constexpr size_t HID = al(TWC + (size_t)CTXL * 8);
constexpr size_t G32 = al(HID + (size_t)DEPTH * LSEQ * 64 * 4);
constexpr size_t AFF = al(G32 + (size_t)MROWS * 32 * 4);
constexpr size_t SELI = al(AFF + (size_t)NB * NE * LSEQ * 4);
constexpr size_t SELS = al(SELI + (size_t)NPAIR * 4);
constexpr size_t SLOT = al(SELS + (size_t)NPAIR * 4);
constexpr size_t SSQ = al(SLOT + (size_t)MROWS * NE * 4);
constexpr size_t CTXC = al(SSQ + (size_t)MROWS * 8 * 4);
constexpr size_t WSCR = al(CTXC + (size_t)NCTX * D * 4);
constexpr size_t WSCR_H = 0, WSCR_H1 = ((size_t)SEQ + 8) * 8, WSCR_Z1 = 2 * WSCR_H1;
constexpr size_t WSCR_PER = al(WSCR_Z1 + (size_t)2 * SEQ * 2) > 262144 ? al(WSCR_Z1 + (size_t)2 * SEQ * 2) : 262144;
constexpr size_t WT_IN = al(WSCR + 256 * WSCR_PER);
constexpr size_t WT_HY = al(WT_IN + (size_t)PN1 * 1024 * 2);
constexpr size_t WT_GB = al(WT_HY + (size_t)HYC * 1024 * 2);
constexpr size_t WT_OUT = al(WT_GB + (size_t)4096 * GB_LD * 2);
constexpr size_t HYB = al(WT_OUT + (size_t)1024 * 1024 * 2);
constexpr size_t BIG = al(HYB + (size_t)MROWS * HY_LD * 2);
constexpr size_t P = BIG;
constexpr size_t HYT = al(P + (size_t)MROWS * PCOLS * 2);
constexpr size_t YBT = al(HYT + (size_t)HYC * MROWS * 2);
constexpr size_t ST_SSD = al(YBT + (size_t)512 * MROWS * 2);
constexpr size_t DEC_SSD = al(ST_SSD + (size_t)32 * NSC * 4096 * 4);
constexpr size_t ST_ML = al(DEC_SSD + (size_t)32 * NSC * 4);
constexpr size_t DEC_ML = al(ST_ML + (size_t)16 * NSC * 144 * 128 * 4);
constexpr size_t ST_HG = al(DEC_ML + (size_t)16 * NSC * 4);
constexpr size_t DEC_HG = al(ST_HG + (size_t)16 * NSC * 16384 * 4);
constexpr size_t MIX_END = al(DEC_HG + (size_t)16 * NSC * 128 * 4);
constexpr size_t T = P;
constexpr size_t XG = BIG;
constexpr size_t HIDB = al(XG + (size_t)NPAIR * 1024 * 2);
constexpr size_t WT_GU = al(HIDB + (size_t)NPAIR * 2048 * 2);
constexpr size_t WT_DN = al(WT_GU + (size_t)NE * 4096 * 1024 * 2);
constexpr size_t MOE_END = al(WT_DN + (size_t)NE * 1024 * 2048 * 2);
constexpr size_t END = MIX_END > MOE_END ? MIX_END : MOE_END;
}

struct Params {
    const float* in[38];
    float* out;
    unsigned char* ws;
    int ph_lo, ph_hi;
};
enum { I_X = 0, I_C, I_CTX, I_CCTX, I_WADA, I_BADA, I_N1G, I_N2G, I_WIN, I_SSD_CW, I_SSD_CB, I_SSD_DTB, I_SSD_ALOG, I_SSD_D, I_SSD_NG,
       I_HY_CW, I_HY_CB, I_HY_W1, I_HY_B1, I_HY_W2, I_HY_B2, I_HY_W3, I_HY_FREQ, I_HY_SKIP, I_ML_CW, I_ML_CB, I_ML_IB, I_ML_FB, I_ML_NG,
       I_HG_LB, I_HG_NG, I_WBR, I_WOUT, I_WROUTER, I_WGATE, I_WUP, I_WDOWN, I_FINALG };

#define XB_TMO      128
#define XB_XCNT(j)  (256  + 64 * (j))
#define XB_XSUB(j)  (1280 + 64 * (j))
#define XB_XGEN(j)  (2304 + 64 * (j))
#define XB_TOP      3328
#define XB_TOPGEN   3392
#define XCD_BAR_WORDS 3456
#define XB_SPIN_CAP (1u << 22)
__device__ __forceinline__ unsigned xb_ld(unsigned* p)              { return __hip_atomic_load(p, __ATOMIC_RELAXED, __HIP_MEMORY_SCOPE_AGENT); }
__device__ __forceinline__ unsigned xb_add(unsigned* p, unsigned v) { return __hip_atomic_fetch_add(p, v, __ATOMIC_RELAXED, __HIP_MEMORY_SCOPE_AGENT); }
__device__ __forceinline__ unsigned xb_xcc_id() { return (unsigned)__builtin_amdgcn_s_getreg((3 << 11) | 20) & 0xFu; }
#define XB_SPIN(cond, bar) do { unsigned _sp = 0; while (cond) { __builtin_amdgcn_s_sleep(1); \
    if ((++_sp & 255u) == 0u) { if (xb_ld(&(bar)[XB_TMO])) break; if (_sp > XB_SPIN_CAP) { atomicAdd(&(bar)[XB_TMO], 1u); break; } } } } while (0)
struct XcdBarrier { unsigned* bar; unsigned x; volatile LAS unsigned* st; };
__device__ __forceinline__ XcdBarrier xcd_barrier_post(unsigned* bar, volatile LAS unsigned* st, bool leader) {
    XcdBarrier b; b.bar = bar; b.x = xb_xcc_id(); b.st = st;
    if (leader) (void)xb_add(&bar[XB_XCNT(b.x)], 1u);
    return b;
}
__device__ __forceinline__ void xcd_barrier_complete(unsigned* bar, unsigned x, unsigned& nloc, unsigned& nx) {
    const unsigned G = gridDim.x * gridDim.y * gridDim.z;
    unsigned sum, cnt, mine, sp = 0u;
    for (;;) {
        sum = 0u; cnt = 0u; mine = 0u;
#pragma unroll
        for (unsigned j = 0; j < 16; ++j) { const unsigned c = xb_ld(&bar[XB_XCNT(j)]); sum += c; cnt += (c > 0u) ? 1u : 0u; mine = (j == x) ? c : mine; }
        if (sum == G) break;
        __builtin_amdgcn_s_sleep(1);
        if ((++sp & 255u) == 0u) { if (xb_ld(&bar[XB_TMO])) break; if (sp > XB_SPIN_CAP) { atomicAdd(&bar[XB_TMO], 1u); break; } }
    }
    nloc = mine > 0u ? mine : 1u; nx = cnt > 0u ? cnt : 1u;
}
__device__ __forceinline__ void xcd_barrier(const XcdBarrier& b, bool leader) {
    ASM_VMCNT0();
    __syncthreads();
    if (leader) {
        unsigned* bar = b.bar;
        __builtin_amdgcn_s_waitcnt(0);
        unsigned nloc = b.st[0], nx = b.st[1];
        if (nloc == 0u) { xcd_barrier_complete(bar, b.x, nloc, nx); b.st[0] = nloc; b.st[1] = nx; }
        const unsigned old = xb_add(&bar[XB_XSUB(b.x)], 1u);
        const unsigned gen = old / nloc;
        if (old + 1u == (gen + 1u) * nloc) {
            __builtin_amdgcn_fence(__ATOMIC_RELEASE, "agent");
            ASM_VMCNT0();
            const unsigned og = xb_add(&bar[XB_TOP], 1u);
            const unsigned tg = og / nx;
            if (og + 1u == (tg + 1u) * nx) xb_add(&bar[XB_TOPGEN], 1u);
            else XB_SPIN(xb_ld(&bar[XB_TOPGEN]) == tg, bar);
            __builtin_amdgcn_fence(__ATOMIC_ACQUIRE, "agent");
            xb_add(&bar[XB_XGEN(b.x)], 1u);
            ASM_VMCNT0();
        } else {
            XB_SPIN(xb_ld(&bar[XB_XGEN(b.x)]) == gen, bar);
            __builtin_amdgcn_fence(__ATOMIC_ACQUIRE, "agent");
            ASM_VMCNT0();
        }
    }
    __syncthreads();
}

namespace pg8 {
constexpr int BM = 256, BK = 64, HALF = 128, HTB = HALF * BK * 2, STAGE_BYTES = 8 * HTB;
__host__ __device__ __forceinline__ int lds_byte(int r, int c) { const int st = (r >> 4) * 2 + (c >> 5), rr = r & 15, cc = c & 31, ob = rr * 64 + cc * 2; return st * 1024 + (ob ^ (((ob >> 9) & 1) << 5)); }
__host__ __device__ __forceinline__ void stage_rc(int b, int& R, int& C) { const int st = b / 1024, sb = b % 1024, swz = sb ^ (((sb >> 9) & 1) << 5); R = (st >> 1) * 16 + swz / 64; C = (st & 1) * 32 + (swz % 64) / 2; }
__host__ __device__ __forceinline__ int perm32(int rho) { const int n = rho >> 4, i = rho & 15; return 8 * (i >> 2) + 4 * n + (i & 3); }
struct Unit { const char* A; const char* B; int nt; int a0, a1, a2; };
template <class Epi, class Sched>
__device__ __forceinline__ void gemm_phase(LAS unsigned char* lds, const int tid, const int lda, const int ldb, Sched& S, const Epi& E) {
    const int wid = __builtin_amdgcn_readfirstlane(tid >> 6), lane = tid & 63, wr = wid >> 2, wc = wid & 3, fr = lane & 15, fq = lane >> 4;
    unsigned voffA[2], voffB[2];
#pragma unroll
    for (int i = 0; i < 2; ++i) { int R, C; stage_rc(tid * 16 + i * 8192, R, C); const int Rb = Epi::PERM ? ((R & ~31) + perm32(R & 31)) : R;
        voffA[i] = (unsigned)(R * lda + C) * 2u; voffB[i] = (unsigned)(Rb * ldb + C) * 2u; }
    const size_t kstep = (size_t)(BK * 2);
    const size_t hstepA = (size_t)HALF * lda * 2, hstepB = (size_t)HALF * ldb * 2;
    const unsigned ldsw = (unsigned)wid * 1024u;
    const int aoff = lds_byte(wr * 64 + fr, fq * 8), boff = lds_byte(wc * 32 + fr, fq * 8);
#define PG8_SA(b, h) (((b) * 2 + (h)) * HTB)
#define PG8_SB(b, h) ((4 + (b) * 2 + (h)) * HTB)
#define PG8_STAGE(bufoff, gbase, voff) do { _Pragma("unroll") for (int _i = 0; _i < 2; ++_i) \
        __builtin_amdgcn_global_load_lds((const unsigned*)((const char*)(gbase) + (voff)[_i]), (LAS unsigned*)(lds + (bufoff) + ldsw + _i * 8192), 16, 0, 0); } while (0)
#define PG8_LDA(dst, b, h) do { _Pragma("unroll") for (int m = 0; m < 4; ++m) _Pragma("unroll") for (int k = 0; k < 2; ++k) dst[m][k] = *(const LAS bf16x8*)(lds + PG8_SA(b, h) + aoff + m * 2048 + k * 1024); } while (0)
#define PG8_LDB(dst, b, h) do { _Pragma("unroll") for (int n = 0; n < 2; ++n) _Pragma("unroll") for (int k = 0; k < 2; ++k) dst[n][k] = *(const LAS bf16x8*)(lds + PG8_SB(b, h) + boff + n * 2048 + k * 1024); } while (0)
#define PG8_MMA(ai, bj, At, Bt) do { __builtin_amdgcn_s_setprio(1); _Pragma("unroll") for (int m = 0; m < 4; ++m) _Pragma("unroll") for (int n = 0; n < 2; ++n) _Pragma("unroll") for (int k = 0; k < 2; ++k) \
        acc[ai][bj][m][n] = __builtin_amdgcn_mfma_f32_16x16x32_bf16(Bt[n][k], At[m][k], acc[ai][bj][m][n], 0, 0, 0); __builtin_amdgcn_s_setprio(0); } while (0)
#define PG8_BAR __builtin_amdgcn_s_barrier()
#define PG8_SCHED __builtin_amdgcn_sched_barrier(0)
    Unit cur, nxt; int ui = 0;
    if (!S.next(0, cur)) return;
    f32x4 acc[2][2][4][2];
#pragma unroll
    for (int a = 0; a < 2; ++a)
#pragma unroll
        for (int b = 0; b < 2; ++b)
#pragma unroll
            for (int m = 0; m < 4; ++m)
#pragma unroll
                for (int n = 0; n < 2; ++n) acc[a][b][m][n] = (f32x4){0.f, 0.f, 0.f, 0.f};
    bf16x8 At[4][2], B0[2][2], B1[2][2];
    const char* cA = cur.A; const char* cB = cur.B;
    PG8_STAGE(PG8_SB(0, 0), cB, voffB); PG8_STAGE(PG8_SA(0, 0), cA, voffA); PG8_STAGE(PG8_SB(0, 1), cB + hstepB, voffB); PG8_STAGE(PG8_SA(0, 1), cA + hstepA, voffA);
    if (wr == 1) PG8_BAR;
    ASM_VMCNT4(); PG8_BAR;
    PG8_STAGE(PG8_SB(1, 0), cB + kstep, voffB); PG8_STAGE(PG8_SA(1, 0), cA + kstep, voffA); PG8_STAGE(PG8_SB(1, 1), cB + hstepB + kstep, voffB);
    ASM_VMCNT6(); PG8_BAR;
    for (;;) {
        const bool has_next = S.next(ui + 1, nxt);
        const char* nA = has_next ? nxt.A : cA; const char* nB = has_next ? nxt.B : cB;
        const int nt = cur.nt;
        for (int t = 0; t < nt; t += 2) {
            const bool last = (t == nt - 2);
            const char* a1 = cA + (size_t)(t + 1) * kstep;
            const char* a2 = last ? nA : cA + (size_t)(t + 2) * kstep; const char* b2 = last ? nB : cB + (size_t)(t + 2) * kstep;
            const char* a3 = a2 + kstep; const char* b3 = b2 + kstep;
            PG8_LDB(B0, 0, 0); PG8_SCHED; PG8_LDA(At, 0, 0); PG8_STAGE(PG8_SA(1, 1), a1 + hstepA, voffA);
            ASM_LGKM8(); PG8_BAR; ASM_LGKM0(); PG8_MMA(0, 0, At, B0); PG8_BAR; PG8_SCHED;
            PG8_LDB(B1, 0, 1); PG8_STAGE(PG8_SB(0, 0), b2, voffB);
            PG8_BAR; ASM_LGKM0(); PG8_MMA(0, 1, At, B1); PG8_BAR;
            PG8_LDA(At, 0, 1); PG8_STAGE(PG8_SA(0, 0), a2, voffA);
            PG8_BAR; ASM_LGKM0(); PG8_MMA(1, 0, At, B0); PG8_BAR; PG8_SCHED;
            PG8_STAGE(PG8_SB(0, 1), b2 + hstepB, voffB);
            ASM_VMCNT6(); PG8_BAR; PG8_MMA(1, 1, At, B1); PG8_BAR;
            PG8_LDB(B0, 1, 0); PG8_SCHED; PG8_LDA(At, 1, 0); PG8_STAGE(PG8_SA(0, 1), a2 + hstepA, voffA);
            ASM_LGKM8(); PG8_BAR; ASM_LGKM0(); PG8_MMA(0, 0, At, B0); PG8_BAR; PG8_SCHED;
            PG8_LDB(B1, 1, 1); PG8_STAGE(PG8_SB(1, 0), b3, voffB);
            PG8_BAR; ASM_LGKM0(); PG8_MMA(0, 1, At, B1); PG8_BAR;
            PG8_LDA(At, 1, 1); PG8_STAGE(PG8_SA(1, 0), a3, voffA);
            PG8_BAR; ASM_LGKM0(); PG8_MMA(1, 0, At, B0); PG8_BAR; PG8_SCHED;
            PG8_STAGE(PG8_SB(1, 1), b3 + hstepB, voffB);
            ASM_VMCNT6(); PG8_BAR; PG8_MMA(1, 1, At, B1); PG8_BAR;
        }
        { int efr = fr, efq = fq;
#ifndef CPU_EMU
          asm volatile("" : "+v"(efr), "+v"(efq));
#endif
          E(acc, cur, wr, wc, efr, efq); }
        if (!has_next) break;
#pragma unroll
        for (int a = 0; a < 2; ++a)
#pragma unroll
            for (int b = 0; b < 2; ++b)
#pragma unroll
                for (int m = 0; m < 4; ++m)
#pragma unroll
                    for (int n = 0; n < 2; ++n) acc[a][b][m][n] = (f32x4){0.f, 0.f, 0.f, 0.f};
        cur = nxt; cA = nA; cB = nB; ++ui;
    }
    ASM_VMCNT0();
    if (wr == 0) PG8_BAR;
    PG8_BAR;
#undef PG8_SA
#undef PG8_SB
#undef PG8_STAGE
#undef PG8_LDA
#undef PG8_LDB
#undef PG8_MMA
#undef PG8_BAR
#undef PG8_SCHED
}
}

struct Frame {
    LAS unsigned char* lds;
    int tid, lane, wave, G, bid;
    unsigned char* ws;
    const Params* p;
};
#define WSP(T, off) ((T*)(F.ws + (off)))
constexpr int PTR_OFF = LDS_BYTES - 16 - 40 * 8;
__device__ __forceinline__ const float* inp(const Frame& F, int i) {
    const unsigned long long v = *(const LAS unsigned long long*)(F.lds + PTR_OFF + i * 8);
    const unsigned lo = __builtin_amdgcn_readfirstlane((unsigned)v), hi = __builtin_amdgcn_readfirstlane((unsigned)(v >> 32));
    return (const float*)(const GAS float*)(((unsigned long long)hi << 32) | lo);
}

__device__ __forceinline__ int row_sample(int row) { return row < NLAT ? row / SEQ : (row - NLAT) / CTXL; }
__device__ __forceinline__ int row_modset(int row) { return row < NLAT ? row / SEQ : 2; }
__device__ __forceinline__ int scan_row(int b, int dir, int j, bool colmajor) {
    if (j < CTXL) { const int t = dir ? (CTXL - 1 - j) : j; return NLAT + b * CTXL + t; }
    int q = j - CTXL; if (dir) q = SEQ - 1 - q;
    const int t = colmajor ? ((q % GROWS) * GRID_W + q / GROWS) : q;
    return b * SEQ + t;
}
__device__ __forceinline__ int row_prev(int row) { if (row < NLAT) return (row % SEQ) == 0 ? -1 : row - 1; return ((row - NLAT) % CTXL) == 0 ? -1 : row - 1; }
__device__ __forceinline__ int row_next(int row) { if (row < NLAT) return (row % SEQ) == SEQ - 1 ? -1 : row + 1; return ((row - NLAT) % CTXL) == CTXL - 1 ? -1 : row + 1; }

template <int NT> __device__ __forceinline__ void tconv_block(const Frame& F, const float* src0, size_t src_ld, bf16_t* dst0, size_t dst_ld) {
    constexpr int KL = NT == 64 ? 64 : 16;
    const int n = F.lane % NT, kq = F.lane / NT, k0 = F.wave * 64 + kq * KL;
    float v[KL];
    if (src0) { const float* sp = src0 + (size_t)k0 * src_ld + n;
#pragma unroll
        for (int k = 0; k < KL; ++k) v[k] = sp[(size_t)k * src_ld]; }
    else {
#pragma unroll
        for (int k = 0; k < KL; ++k) v[k] = 0.f; }
    bf16_t* dp = dst0 + (size_t)n * dst_ld + k0;
#pragma unroll
    for (int k = 0; k < KL; k += 8) { u32x4 w; w.x = cvt_pk_bf16(v[k], v[k + 1]); w.y = cvt_pk_bf16(v[k + 2], v[k + 3]); w.z = cvt_pk_bf16(v[k + 4], v[k + 5]); w.w = cvt_pk_bf16(v[k + 6], v[k + 7]);
        GST(u32x4, dp + k) = w; }
}
__device__ __forceinline__ int win_srccol(int r) {
    if (r < 1280) return r;
    if (r < 3328) return 2832 + (r - 1280);
    if (r < 5888) return 4896 + (r - 3328);
    if (r < 5904) return 1280 + (r - 5888);
    if (r < 5920) return 4880 + (r - 5904);
    return -1;
}
constexpr int CONVA_WIN = (PN1 / 16) * 2, CONVA_HY = (HYC / 64) * 2, CONVA_GATE = (4096 / 64) * 2, CONVA_BR = (4096 / 64), CONVA_OUT = (1024 / 64) * 2;
constexpr int CONVA_ITEMS = CONVA_WIN + CONVA_HY + CONVA_GATE + CONVA_BR + CONVA_OUT;
__device__ __forceinline__ void conv_dense_item(const Frame& F, int l, int it) {
    const float* w_in = inp(F, I_WIN) + (size_t)l * D * WIN_COLS;
    if (it < CONVA_WIN) { const int rb = it >> 1, kb = it & 1; const int sc = win_srccol(rb * 16);
        tconv_block<16>(F, sc < 0 ? nullptr : w_in + (size_t)kb * 512 * WIN_COLS + sc, WIN_COLS, WSP(bf16_t, wsmap::WT_IN) + (size_t)rb * 16 * 1024 + kb * 512, 1024); return; }
    it -= CONVA_WIN;
    if (it < CONVA_HY) { const int rb = it >> 1, kb = it & 1;
        tconv_block<64>(F, w_in + (size_t)kb * 512 * WIN_COLS + 1296 + rb * 64, WIN_COLS, WSP(bf16_t, wsmap::WT_HY) + (size_t)rb * 64 * 1024 + kb * 512, 1024); return; }
    it -= CONVA_HY;
    if (it < CONVA_GATE) { const int rb = it >> 1, kb = it & 1;
        tconv_block<64>(F, w_in + (size_t)kb * 512 * WIN_COLS + 7456 + rb * 64, WIN_COLS, WSP(bf16_t, wsmap::WT_GB) + (size_t)rb * 64 * GB_LD + kb * 512, GB_LD); return; }
    it -= CONVA_GATE;
    if (it < CONVA_BR) { const int r0 = it * 64, br = r0 >> 10, n0 = r0 & 1023;
        const float* wb = inp(F, I_WBR) + ((size_t)l * 4 + br) * BW * D;
        tconv_block<64>(F, wb + n0, D, WSP(bf16_t, wsmap::WT_GB) + (size_t)r0 * GB_LD + 1024, GB_LD); return; }
    it -= CONVA_BR;
    { const int rb = it >> 1, kb = it & 1; const float* wo = inp(F, I_WOUT) + (size_t)l * D * D;
      tconv_block<64>(F, wo + (size_t)kb * 512 * D + rb * 64, D, WSP(bf16_t, wsmap::WT_OUT) + (size_t)rb * 64 * 1024 + kb * 512, 1024); }
}
constexpr int CONVM_GU = NE * (4096 / 64) * 2, CONVM_DN = NE * (1024 / 64) * 4, CONVM_ITEMS = CONVM_GU + CONVM_DN;
__device__ __forceinline__ void conv_moe_item(const Frame& F, int l, int it) {
    if (it < CONVM_GU) { const int e = it / 128, r = it % 128, rb = r >> 1, kb = r & 1; const int r0 = rb * 64, pn = r0 >> 8, h = (r0 >> 7) & 1, i0 = r0 & 127;
        const float* src = inp(F, h ? I_WUP : I_WGATE) + ((size_t)l * NE + e) * D * DE + (size_t)kb * 512 * DE + pn * 128 + i0;
        tconv_block<64>(F, src, DE, WSP(bf16_t, wsmap::WT_GU) + ((size_t)e * 4096 + r0) * 1024 + kb * 512, 1024); return; }
    it -= CONVM_GU;
    { const int e = it / 64, r = it % 64, rb = r >> 2, kb = r & 3;
      const float* src = inp(F, I_WDOWN) + ((size_t)l * NE + e) * DE * D + (size_t)kb * 512 * D + rb * 64;
      tconv_block<64>(F, src, D, WSP(bf16_t, wsmap::WT_DN) + ((size_t)e * 1024 + rb * 64) * 2048 + kb * 512, 2048); }
}

__device__ __forceinline__ float sin_rad(float x) { const float r = x * 0.15915494309189535f; return __builtin_amdgcn_sinf(r - floorf(r)); }
constexpr int A0_MOD = DEPTH * (6144 / 64);
constexpr int A0_HID = DEPTH * (LSEQ / 8);
constexpr int A0_MISC = 1 + (SEQ + CTXL + NTHREADS - 1) / NTHREADS;
constexpr int A0_ITEMS = A0_MOD + A0_HID + A0_MISC + CONVA_ITEMS;
__device__ __forceinline__ void phase_a0(const Frame& F) {
    for (int it = F.bid; it < A0_ITEMS; it += F.G) {
        if (it < A0_MOD) {
            const int l = it / 96, j = (it % 96) * 64 + (F.tid & 63), ds = F.tid >> 6;
            const float* wa = inp(F, I_WADA) + (size_t)l * D * 6144;
            float a0 = 0.f, a1 = 0.f, a2 = 0.f;
            LAS float* sv = (LAS float*)(F.lds + 8192);
            __syncthreads();
            for (int i = F.tid; i < 3 * D; i += NTHREADS) sv[i] = siluf_(i < 2 * D ? inp(F, I_C)[i] : inp(F, I_CCTX)[i - 2 * D]);
            __syncthreads();
#pragma unroll 16
            for (int d = ds * 128; d < ds * 128 + 128; ++d) { const float w = wa[(size_t)d * 6144 + j]; a0 += sv[d] * w; a1 += sv[D + d] * w; a2 += sv[2 * D + d] * w; }
            LAS float* red = (LAS float*)F.lds;
            __syncthreads();
            red[(ds * 3 + 0) * 64 + (F.tid & 63)] = a0; red[(ds * 3 + 1) * 64 + (F.tid & 63)] = a1; red[(ds * 3 + 2) * 64 + (F.tid & 63)] = a2;
            __syncthreads();
            if (F.tid < 192) { const int s = F.tid >> 6, jj = F.tid & 63; float a = 0.f;
                for (int q = 0; q < 8; ++q) a += red[(q * 3 + s) * 64 + jj];
                const int jg = (it % 96) * 64 + jj;
                WSP(float, wsmap::MOD)[((size_t)l * 3 + s) * 6144 + jg] = a + inp(F, I_BADA)[(size_t)l * 6144 + jg]; }
            continue; }
        int i2 = it - A0_MOD;
        if (i2 < A0_HID) {
            const int l = i2 / (LSEQ / 8), pg = i2 % (LSEQ / 8), pl = F.tid >> 6, j = F.tid & 63, gp = pg * 8 + pl;
            const int n = gp < SEQ ? SEQ : CTXL, pos = gp < SEQ ? gp : gp - SEQ;
            LAS float* h1 = (LAS float*)F.lds;
            const float* w1 = inp(F, I_HY_W1) + (size_t)l * 17 * 64; const float* w2 = inp(F, I_HY_W2) + (size_t)l * 64 * 64;
            const float f0 = inp(F, I_HY_FREQ)[(l * 2 + 0) * 64 + j], f1 = inp(F, I_HY_FREQ)[(l * 2 + 1) * 64 + j];
            float a = inp(F, I_HY_B1)[l * 64 + j] + ((float)pos / (float)(n > 1 ? n - 1 : 1)) * w1[j];
            static_assert((SEQ & (SEQ - 1)) == 0 && (CTXL & (CTXL - 1)) == 0, "filter lengths are powers of two");
            const float rn = 1.0f / (float)n;
#pragma unroll
            for (int bnd = 1; bnd <= 8; ++bnd) { const float fr = (float)((pos * bnd) & (n - 1)) * rn;
                a += __builtin_amdgcn_cosf(fr) * w1[bnd * 64 + j] + __builtin_amdgcn_sinf(fr) * w1[(8 + bnd) * 64 + j]; }
            __syncthreads();
            h1[pl * 64 + j] = sin_rad(f0 * a);
            __syncthreads();
            float a2 = inp(F, I_HY_B2)[l * 64 + j];
            for (int i = 0; i < 64; ++i) a2 += h1[pl * 64 + i] * w2[i * 64 + j];
            WSP(bf16_t, wsmap::HID)[((size_t)l * LSEQ + gp) * 64 + j] = f2bf1(sin_rad(f1 * a2));
            continue; }
        i2 -= A0_HID;
        if (i2 < A0_MISC) {
            if (i2 == 0) {
                const int c = F.tid;
                float mx = -1e30f; for (int l = 0; l < DEPTH; ++l) mx = fmaxf(mx, inp(F, I_HG_LB)[l * 512 + c]);
                float den = 0.f; for (int l = 0; l < DEPTH; ++l) den += __expf(inp(F, I_HG_LB)[l * 512 + c] - mx);
                const float p0 = __expf(inp(F, I_HG_LB)[c] - mx) / den; float cum = 0.f;
                for (int l = 0; l < DEPTH; ++l) { cum += __expf(inp(F, I_HG_LB)[l * 512 + c] - mx) / den; WSP(float, wsmap::LB)[l * 512 + c] = fmaxf(cum - p0, 0.f); }
            } else { const int k = (i2 - 1) * NTHREADS + F.tid;
                if (k < SEQ) { float s, c; sincospif((float)k / (float)SEQ, &s, &c); WSP(f32x2, wsmap::TWL)[k] = (f32x2){c, -s}; }
                else if (k < SEQ + CTXL) { const int kk = k - SEQ; float s, c; sincospif((float)kk / (float)CTXL, &s, &c); WSP(f32x2, wsmap::TWC)[kk] = (f32x2){c, -s}; } }
            continue; }
        i2 -= A0_MISC;
        conv_dense_item(F, 0, i2);
    }
}

__device__ __forceinline__ void load_row16(const float* p, int lane, f32x4 (&v)[4]) {
#pragma unroll
    for (int i = 0; i < 4; ++i) v[i] = GLD(f32x4, p + i * 256 + lane * 4);
}
__device__ __forceinline__ void moe_combine_row(const Frame& F, int row, int lane, const float* g2, f32x4 (&v)[4]) {
    typedef int i32x4 __attribute__((ext_vector_type(4)));
    const int* slot = WSP(int, wsmap::SLOT) + (size_t)row * NE;
    i32x4 sl[4];
#pragma unroll
    for (int q = 0; q < 4; ++q) sl[q] = GLD(i32x4, slot + 4 * q);
    f32x4 acc[4];
#pragma unroll
    for (int i = 0; i < 4; ++i) acc[i] = (f32x4){0.f, 0.f, 0.f, 0.f};
#pragma unroll
    for (int e = 0; e < NE; ++e) { const int pr = sl[e >> 2][e & 3]; if (pr < 0) continue;
        const bf16_t* z = WSP(bf16_t, wsmap::XG) + (size_t)pr * 1024;
#pragma unroll
        for (int i = 0; i < 4; ++i) { const u32x2 w = GLD(u32x2, z + i * 256 + lane * 4);
            acc[i][0] += bflo(w.x); acc[i][1] += bfhi(w.x); acc[i][2] += bflo(w.y); acc[i][3] += bfhi(w.y); } }
#pragma unroll
    for (int i = 0; i < 4; ++i) { const f32x4 g = GLD(f32x4, g2 + i * 256 + lane * 4); v[i] += g * acc[i]; }
}
__device__ __forceinline__ void moe_combine_rows2(const Frame& F, int r0, int lane, const float* g2a, const float* g2b, f32x4 (&v)[2][4]) {
    typedef int i32x4 __attribute__((ext_vector_type(4)));
    i32x4 sl[2][4];
#pragma unroll
    for (int rr = 0; rr < 2; ++rr)
#pragma unroll
        for (int q = 0; q < 4; ++q) sl[rr][q] = GLD(i32x4, WSP(int, wsmap::SLOT) + (size_t)(r0 + rr) * NE + 4 * q);
    int pk[2][4], cnt[2];
#pragma unroll
    for (int rr = 0; rr < 2; ++rr) { int c = 0;
#pragma unroll
        for (int k = 0; k < 4; ++k) pk[rr][k] = -1;
#pragma unroll
        for (int e = 0; e < NE; ++e) { const int s = __builtin_amdgcn_readfirstlane(sl[rr][e >> 2][e & 3]); const bool val = s >= 0;
#pragma unroll
            for (int k = 0; k < 4; ++k) pk[rr][k] = (val && c == k) ? s : pk[rr][k];
            c += val ? 1 : 0; }
        cnt[rr] = c; }
    u32x2 w[2][4][4];
#pragma unroll
    for (int rr = 0; rr < 2; ++rr)
#pragma unroll
        for (int k = 0; k < 4; ++k) { const bf16_t* z = WSP(bf16_t, wsmap::XG) + (size_t)(pk[rr][k] < 0 ? 0 : pk[rr][k]) * 1024;
#pragma unroll
            for (int i = 0; i < 4; ++i) w[rr][k][i] = GLD(u32x2, z + i * 256 + lane * 4); }
#pragma unroll
    for (int rr = 0; rr < 2; ++rr) { f32x4 acc[4];
#pragma unroll
        for (int i = 0; i < 4; ++i) acc[i] = (f32x4){0.f, 0.f, 0.f, 0.f};
#pragma unroll
        for (int k = 0; k < 4; ++k) { if (pk[rr][k] < 0) continue;
#pragma unroll
            for (int i = 0; i < 4; ++i) { const u32x2 ww = w[rr][k][i]; acc[i][0] += bflo(ww.x); acc[i][1] += bfhi(ww.x); acc[i][2] += bflo(ww.y); acc[i][3] += bfhi(ww.y); } }
        if (cnt[rr] > 4) { int seen = 0;
#pragma unroll 1
            for (int e = 0; e < NE; ++e) { const int s = __builtin_amdgcn_readfirstlane(GLD(int, WSP(int, wsmap::SLOT) + (size_t)(r0 + rr) * NE + e)); if (s < 0) continue;
                if (seen >= 4) { const bf16_t* z = WSP(bf16_t, wsmap::XG) + (size_t)s * 1024;
#pragma unroll
                    for (int i = 0; i < 4; ++i) { const u32x2 ww = GLD(u32x2, z + i * 256 + lane * 4); acc[i][0] += bflo(ww.x); acc[i][1] += bfhi(ww.x); acc[i][2] += bflo(ww.y); acc[i][3] += bfhi(ww.y); } }
                ++seen; } }
        const float* g2 = rr ? g2b : g2a;
#pragma unroll
        for (int i = 0; i < 4; ++i) { const f32x4 g = GLD(f32x4, g2 + i * 256 + lane * 4); v[rr][i] += g * acc[i]; } }
}
__device__ __forceinline__ float* stream_row(const Frame& F, int row) { return row < NLAT ? (float*)(GAS float*)F.p->out + (size_t)row * D : WSP(float, wsmap::CTXC) + (size_t)(row - NLAT) * D; }
__device__ __forceinline__ const float* input_row(const Frame& F, int row) { return row < NLAT ? inp(F, I_X) + (size_t)row * D : inp(F, I_CTX) + (size_t)(row - NLAT) * D; }
__device__ __forceinline__ void norm_mod_store(const f32x4 (&v)[4], int lane, const float* g, const float* shift, const float* scale, bf16_t* dst, f32x4 (*hout)[4]) {
    float ss = 0.f;
#pragma unroll
    for (int i = 0; i < 4; ++i) ss += v[i][0] * v[i][0] + v[i][1] * v[i][1] + v[i][2] * v[i][2] + v[i][3] * v[i][3];
    ss = wave_sum(ss);
    const float rstd = __builtin_amdgcn_rsqf(ss * (1.0f / D) + 1e-6f);
#pragma unroll
    for (int i = 0; i < 4; ++i) { const int c = i * 256 + lane * 4;
        const f32x4 gg = GLD(f32x4, g + c), sh = GLD(f32x4, shift + c), sc = GLD(f32x4, scale + c);
        f32x4 h = v[i] * rstd * gg * (sc + 1.0f) + sh;
        if (hout) (*hout)[i] = h;
        u32x2 w; w.x = cvt_pk_bf16(h[0], h[1]); w.y = cvt_pk_bf16(h[2], h[3]);
        GST(u32x2, dst + c) = w; }
}
__device__ __forceinline__ void phase_norm1(const Frame& F, int l) {
    const int nrows = MROWS;
    for (int r0 = (F.bid * 8 + F.wave) * 2; r0 < nrows; r0 += F.G * 8 * 2) {
        f32x4 v[2][4];
#pragma unroll
        for (int rr = 0; rr < 2; ++rr) { const int row = r0 + rr;
            if (l == 0) load_row16(input_row(F, row), F.lane, v[rr]); else load_row16(stream_row(F, row), F.lane, v[rr]); }
        if (l > 0) moe_combine_rows2(F, r0, F.lane, WSP(float, wsmap::MOD) + ((size_t)(l - 1) * 3 + row_modset(r0)) * 6144 + 5 * 1024, WSP(float, wsmap::MOD) + ((size_t)(l - 1) * 3 + row_modset(r0 + 1)) * 6144 + 5 * 1024, v);
#pragma unroll
        for (int rr = 0; rr < 2; ++rr) { const int row = r0 + rr; const int ms = row_modset(row);
            if (l > 0) { float* xr = stream_row(F, row);
#pragma unroll
                for (int i = 0; i < 4; ++i) GST(f32x4, xr + i * 256 + F.lane * 4) = v[rr][i]; }
            const float* mod = WSP(float, wsmap::MOD) + ((size_t)l * 3 + ms) * 6144;
            norm_mod_store(v[rr], F.lane, inp(F, I_N1G) + (size_t)l * D, mod, mod + 1024, WSP(bf16_t, wsmap::HYB) + (size_t)row * HY_LD, nullptr); }
    }
}

constexpr int Q_WORD0 = 4096;
__device__ __forceinline__ int q_pull(const Frame& F, int q) {
    volatile LAS int* slot = (volatile LAS int*)(F.lds + LDS_BYTES - 32);
    __syncthreads();
    if (F.tid == 0) *slot = (int)__hip_atomic_fetch_add((unsigned*)(F.ws + wsmap::CTL) + Q_WORD0 + q * 64, 1u, __ATOMIC_RELAXED, __HIP_MEMORY_SCOPE_AGENT);
    __syncthreads();
    return *slot;
}
__device__ __forceinline__ void q_issue(const Frame& F, int q, int& nxt) {
    if (F.tid == 0) nxt = (int)__hip_atomic_fetch_add((unsigned*)(F.ws + wsmap::CTL) + Q_WORD0 + q * 64, 1u, __ATOMIC_RELAXED, __HIP_MEMORY_SCOPE_AGENT);
}
__device__ __forceinline__ int q_take(const Frame& F, int nxt) {
    volatile LAS int* slot = (volatile LAS int*)(F.lds + LDS_BYTES - 32);
    __syncthreads();
    if (F.tid == 0) *slot = nxt;
    __syncthreads();
    return *slot;
}
__device__ __forceinline__ void drain_moe_conv(const Frame& F, int l) {
    for (;;) { const int it = q_pull(F, l * 8 + 7); if (it >= CONVM_ITEMS) break; conv_moe_item(F, l, it); }
}
using pg8::Unit;
typedef f32x4 AccT[2][2][4][2];
__device__ __forceinline__ int xcd_vc(int bid, int G) { return (G & 7) == 0 ? (bid & 7) * (G >> 3) + (bid >> 3) : bid; }
struct SchedG1 { int G, c, nM, nN; const char* A; const char* B; size_t astep, bstep;
    __device__ __forceinline__ bool next(int i, Unit& u) const { const long L = (long)i * G + c; if (L >= (long)nM * nN) return false;
        const int pm = (int)(L / nN), pn = (int)(L % nN); u.A = A + (size_t)pm * astep; u.B = B + (size_t)pn * bstep; u.nt = 16; u.a0 = pm; u.a1 = pn; u.a2 = 0; return true; } };
struct EpiStoreBf16 { static constexpr bool PERM = true; bf16_t* O; size_t ld; float* G32; int small_pn;
    __device__ __forceinline__ void operator()(const AccT& acc, const Unit& u, int wr, int wc, int fr, int fq) const {
        const int row0 = u.a0 * 256 + wr * 64 + fr;
        if (u.a1 == small_pn) { if (wc == 0) {
#pragma unroll
            for (int ai = 0; ai < 2; ++ai)
#pragma unroll
                for (int m = 0; m < 4; ++m) { __builtin_amdgcn_sched_barrier(0); float* gp = G32 + (unsigned)((row0 + ai * 128 + m * 16) * 32 + 8 * fq);
                    GST(f32x4, gp) = acc[ai][0][m][0]; GST(f32x4, gp + 4) = acc[ai][0][m][1]; } }
            return; }
        const int col0 = u.a1 * 256 + wc * 32 + 8 * fq;
#pragma unroll
        for (int ai = 0; ai < 2; ++ai)
#pragma unroll
            for (int m = 0; m < 4; ++m) { __builtin_amdgcn_sched_barrier(0); bf16_t* rp = O + (unsigned)((row0 + ai * 128 + m * 16) * (int)ld + col0);
#pragma unroll
                for (int bj = 0; bj < 2; ++bj) { const f32x4 v0 = acc[ai][bj][m][0], v1 = acc[ai][bj][m][1];
                    u32x4 w; w.x = cvt_pk_bf16(v0[0], v0[1]); w.y = cvt_pk_bf16(v0[2], v0[3]); w.z = cvt_pk_bf16(v1[0], v1[1]); w.w = cvt_pk_bf16(v1[2], v1[3]);
                    GST(u32x4, rp + bj * 128) = w; } }
    } };
__device__ __forceinline__ void phase_proj(const Frame& F) {
    { SchedG1 S{F.G, F.bid, MT, PN1 / 256, (const char*)WSP(bf16_t, wsmap::HYB), (const char*)WSP(bf16_t, wsmap::WT_IN), (size_t)256 * HY_LD * 2, (size_t)256 * 1024 * 2};
      EpiStoreBf16 E{WSP(bf16_t, wsmap::P), (size_t)PCOLS, WSP(float, wsmap::G32), PN1 / 256 - 1};
      pg8::gemm_phase(F.lds, F.tid, HY_LD, 1024, S, E); }
    { const int extra = (MT * (PN1 / 256)) % F.G;
      SchedG1 S{F.G, (F.bid + F.G - extra) % F.G, HYC / 256, MT, (const char*)WSP(bf16_t, wsmap::WT_HY), (const char*)WSP(bf16_t, wsmap::HYB), (size_t)256 * 1024 * 2, (size_t)256 * HY_LD * 2};
      EpiStoreBf16 E{WSP(bf16_t, wsmap::HYT), (size_t)MROWS, nullptr, -1};
      pg8::gemm_phase(F.lds, F.tid, 1024, HY_LD, S, E); }
}
struct SchedGB { int G, c, nsu; const char* hyb; const char* wgb;
    __device__ __forceinline__ bool next(int i, Unit& u) const { const int s = i >> 3, sub = i & 7; const long L = (long)s * G + c; if (L >= nsu) return false;
        const int pm = (int)(L >> 2), j = (int)(L & 3), br = sub >> 1, kind = sub & 1;
        u.A = hyb + (size_t)pm * 256 * HY_LD * 2 + (kind ? 0 : (size_t)(1024 + br * 512) * 2);
        u.B = wgb + (size_t)(br * 1024 + j * 256) * GB_LD * 2 + (kind ? 0 : (size_t)1024 * 2);
        u.nt = kind ? 16 : 8; u.a0 = pm; u.a1 = j; u.a2 = sub; return true; } };
struct EpiGB { static constexpr bool PERM = true; bf16_t* PB; bf16_t* T; const float* ssq;
    __device__ __forceinline__ void operator()(const AccT& acc, const Unit& u, int wr, int wc, int fr, int fq) const {
        const int br = u.a2 >> 1, kind = u.a2 & 1, tid = (wr * 4 + wc) * 64 + fq * 16 + fr;
        const int row0 = u.a0 * 256 + wr * 64 + fr, col0 = u.a1 * 256 + wc * 32 + 8 * fq;
#pragma unroll
        for (int ai = 0; ai < 2; ++ai) { __builtin_amdgcn_sched_barrier(0);
            if (!kind) {
#pragma unroll
                for (int m = 0; m < 4; ++m)
#pragma unroll
                    for (int bj = 0; bj < 2; ++bj) { const f32x4 v0 = acc[ai][bj][m][0], v1 = acc[ai][bj][m][1];
                        u32x4 w; w.x = cvt_pk_bf16(v0[0], v0[1]); w.y = cvt_pk_bf16(v0[2], v0[3]); w.z = cvt_pk_bf16(v1[0], v1[1]); w.w = cvt_pk_bf16(v1[2], v1[3]);
                        GST(u32x4, PB + ((unsigned)tid * 8u + (unsigned)(((ai * 4 + m) * 2 + bj) * NTHREADS * 8))) = w; }
                continue; }
#pragma unroll
            for (int mh = 0; mh < 2; ++mh) { __builtin_amdgcn_sched_barrier(0);
                u32x4 pb[2][2], tt[2][2]; float rs[2];
#pragma unroll
                for (int mm = 0; mm < 2; ++mm) { const int m = mh * 2 + mm, row = row0 + ai * 128 + m * 16; rs[mm] = 1.0f;
#pragma unroll
                    for (int bj = 0; bj < 2; ++bj) { pb[mm][bj] = GLD(u32x4, PB + ((unsigned)tid * 8u + (unsigned)(((ai * 4 + m) * 2 + bj) * NTHREADS * 8)));
                        tt[mm][bj] = br ? GLD(u32x4, T + (unsigned)(row * 1024 + col0 + bj * 128)) : (u32x4){0u, 0u, 0u, 0u}; }
                    if (br == 0) { const f32x4 s0 = GLD(f32x4, ssq + (unsigned)(row * 8)), s1 = GLD(f32x4, ssq + (unsigned)(row * 8 + 4));
                        rs[mm] = __builtin_amdgcn_rsqf(((s0[0] + s0[1]) + (s0[2] + s0[3]) + (s1[0] + s1[1]) + (s1[2] + s1[3])) * (1.0f / 512.0f) + 1e-6f); } }
#pragma unroll
                for (int mm = 0; mm < 2; ++mm) { const int m = mh * 2 + mm, row = row0 + ai * 128 + m * 16;
#pragma unroll
                    for (int bj = 0; bj < 2; ++bj) { const f32x4 v0 = acc[ai][bj][m][0], v1 = acc[ai][bj][m][1]; const u32x4 p = pb[mm][bj], t = tt[mm][bj]; const float r = rs[mm];
                        float o[8];
                        o[0] = sigmoidf_(v0[0]) * bflo(p.x) * r + bflo(t.x); o[1] = sigmoidf_(v0[1]) * bfhi(p.x) * r + bfhi(t.x); o[2] = sigmoidf_(v0[2]) * bflo(p.y) * r + bflo(t.y); o[3] = sigmoidf_(v0[3]) * bfhi(p.y) * r + bfhi(t.y);
                        o[4] = sigmoidf_(v1[0]) * bflo(p.z) * r + bflo(t.z); o[5] = sigmoidf_(v1[1]) * bfhi(p.z) * r + bfhi(t.z); o[6] = sigmoidf_(v1[2]) * bflo(p.w) * r + bflo(t.w); o[7] = sigmoidf_(v1[3]) * bfhi(p.w) * r + bfhi(t.w);
                        u32x4 w; w.x = cvt_pk_bf16(o[0], o[1]); w.y = cvt_pk_bf16(o[2], o[3]); w.z = cvt_pk_bf16(o[4], o[5]); w.w = cvt_pk_bf16(o[6], o[7]);
                        GST(u32x4, T + (unsigned)(row * 1024 + col0 + bj * 128)) = w; } } } }
    } };
__device__ __forceinline__ void phase_gate_branch(const Frame& F, int l) {
    const int mt = (l < DEPTH - 1) ? MT : MT_LAT;
    SchedGB S{F.G, xcd_vc(F.bid, F.G), mt * 4, (const char*)WSP(bf16_t, wsmap::HYB), (const char*)WSP(bf16_t, wsmap::WT_GB)};
    EpiGB E{(bf16_t*)(F.ws + wsmap::WSCR + (size_t)F.bid * wsmap::WSCR_PER), WSP(bf16_t, wsmap::T), WSP(float, wsmap::SSQ)};
    pg8::gemm_phase(F.lds, F.tid, HY_LD, GB_LD, S, E);
    drain_moe_conv(F, l);
}
struct EpiOut { static constexpr bool PERM = false; const Frame* F; int l;
    __device__ __forceinline__ void operator()(const AccT& acc, const Unit& u, int wr, int wc, int fr, int fq) const {
        const int row0 = u.a0 * 256 + wr * 64 + fr, col0 = u.a1 * 256 + wc * 32 + 4 * fq;
#pragma unroll
        for (int ai = 0; ai < 2; ++ai)
#pragma unroll
            for (int mh = 0; mh < 2; ++mh) { __builtin_amdgcn_sched_barrier(0);
                f32x4 xs[2][2][2], gs[2][2][2];
#pragma unroll
                for (int mm = 0; mm < 2; ++mm) { const int row = row0 + ai * 128 + (mh * 2 + mm) * 16;
                    const float* g1 = (const float*)(F->ws + wsmap::MOD) + ((size_t)l * 3 + row_modset(row)) * 6144 + 2 * 1024;
                    const float* src = (l == 0) ? input_row(*F, row) : stream_row(*F, row);
#pragma unroll
                    for (int bj = 0; bj < 2; ++bj)
#pragma unroll
                        for (int n = 0; n < 2; ++n) { const int c = col0 + bj * 128 + n * 16; xs[mm][bj][n] = GLD(f32x4, src + c); gs[mm][bj][n] = GLD(f32x4, g1 + c); } }
#pragma unroll
                for (int mm = 0; mm < 2; ++mm) { const int m = mh * 2 + mm; float* dst = stream_row(*F, row0 + ai * 128 + m * 16);
#pragma unroll
                    for (int bj = 0; bj < 2; ++bj)
#pragma unroll
                        for (int n = 0; n < 2; ++n) GST(f32x4, dst + col0 + bj * 128 + n * 16) = xs[mm][bj][n] + gs[mm][bj][n] * acc[ai][bj][m][n]; } }
    } };
__device__ __forceinline__ void phase_outproj(const Frame& F, int l) {
    const int mt = (l < DEPTH - 1) ? MT : MT_LAT;
    SchedG1 S{F.G, xcd_vc(F.bid, F.G), mt, 4, (const char*)WSP(bf16_t, wsmap::T), (const char*)WSP(bf16_t, wsmap::WT_OUT), (size_t)256 * 1024 * 2, (size_t)256 * 1024 * 2};
    EpiOut E{&F, l};
    pg8::gemm_phase(F.lds, F.tid, 1024, 1024, S, E);
}
constexpr int RT_LAT = NPAIR_LAT / 256, RT_ALL = NPAIR / 256;
__device__ __forceinline__ int rt_expert(int rt) { return rt < RT_LAT ? (rt / (GP_LAT / 256)) % NE : ((rt - RT_LAT) / (GP_CTX / 256)) % NE; }
struct SchedMoe { int G, c, nrt, nN, nt; const char* A; const char* B; size_t astep, bstep_e, bstep_n;
    __device__ __forceinline__ bool next(int i, Unit& u) const { const long L = (long)i * G + c; if (L >= (long)nrt * nN) return false;
        int rt, pn;
        if (nN == 16) { const int blk = (int)(L >> 5), w = (int)(L & 31); rt = (blk >> 1) * 4 + (w & 3); pn = (blk & 1) * 8 + (w >> 2); }
        else { rt = (int)(L / nN); pn = (int)(L % nN); }
        const int e = rt_expert(rt);
        u.A = A + (size_t)rt * astep; u.B = B + (size_t)e * bstep_e + (size_t)pn * bstep_n; u.nt = nt; u.a0 = rt; u.a1 = pn; u.a2 = e; return true; } };
struct EpiGU { static constexpr bool PERM = true; bf16_t* H;
    __device__ __forceinline__ void operator()(const AccT& acc, const Unit& u, int wr, int wc, int fr, int fq) const {
        const int row0 = u.a0 * 256 + wr * 64 + fr, col0 = u.a1 * 128 + wc * 32 + 8 * fq;
#pragma unroll
        for (int ai = 0; ai < 2; ++ai)
#pragma unroll
            for (int m = 0; m < 4; ++m) { __builtin_amdgcn_sched_barrier(0); const f32x4 g0 = acc[ai][0][m][0], g1 = acc[ai][0][m][1], u0 = acc[ai][1][m][0], u1 = acc[ai][1][m][1];
                u32x4 w; w.x = cvt_pk_bf16(siluf_(g0[0]) * u0[0], siluf_(g0[1]) * u0[1]); w.y = cvt_pk_bf16(siluf_(g0[2]) * u0[2], siluf_(g0[3]) * u0[3]);
                w.z = cvt_pk_bf16(siluf_(g1[0]) * u1[0], siluf_(g1[1]) * u1[1]); w.w = cvt_pk_bf16(siluf_(g1[2]) * u1[2], siluf_(g1[3]) * u1[3]);
                GST(u32x4, H + (unsigned)((row0 + ai * 128 + m * 16) * 2048 + col0)) = w; }
    } };
struct EpiDown { static constexpr bool PERM = true; bf16_t* Z; const float* score;
    __device__ __forceinline__ void operator()(const AccT& acc, const Unit& u, int wr, int wc, int fr, int fq) const {
        const int row0 = u.a0 * 256 + wr * 64 + fr, col0 = u.a1 * 256 + wc * 32 + 8 * fq;
        float scv[2][4];
#pragma unroll
        for (int ai = 0; ai < 2; ++ai)
#pragma unroll
            for (int m = 0; m < 4; ++m) scv[ai][m] = GLD(float, score + row0 + ai * 128 + m * 16);
#pragma unroll
        for (int ai = 0; ai < 2; ++ai)
#pragma unroll
            for (int m = 0; m < 4; ++m) { __builtin_amdgcn_sched_barrier(0); const int row = row0 + ai * 128 + m * 16; const float sc = scv[ai][m];
#pragma unroll
                for (int bj = 0; bj < 2; ++bj) { const f32x4 v0 = acc[ai][bj][m][0] * sc, v1 = acc[ai][bj][m][1] * sc;
                    u32x4 w; w.x = cvt_pk_bf16(v0[0], v0[1]); w.y = cvt_pk_bf16(v0[2], v0[3]); w.z = cvt_pk_bf16(v1[0], v1[1]); w.w = cvt_pk_bf16(v1[2], v1[3]);
                    GST(u32x4, Z + (unsigned)(row * 1024 + col0 + bj * 128)) = w; } }
    } };
__device__ __forceinline__ void phase_moe_up(const Frame& F, int l) {
    SchedMoe S{F.G, xcd_vc(F.bid, F.G), (l < DEPTH - 1) ? RT_ALL : RT_LAT, 16, 16, (const char*)WSP(bf16_t, wsmap::XG), (const char*)WSP(bf16_t, wsmap::WT_GU), (size_t)256 * 1024 * 2, (size_t)4096 * 1024 * 2, (size_t)256 * 1024 * 2};
    EpiGU E{WSP(bf16_t, wsmap::HIDB)};
    pg8::gemm_phase(F.lds, F.tid, 1024, 1024, S, E);
}
__device__ __forceinline__ void phase_moe_down(const Frame& F, int l) {
    SchedMoe S{F.G, xcd_vc(F.bid, F.G), (l < DEPTH - 1) ? RT_ALL : RT_LAT, 4, 32, (const char*)WSP(bf16_t, wsmap::HIDB), (const char*)WSP(bf16_t, wsmap::WT_DN), (size_t)256 * 2048 * 2, (size_t)1024 * 2048 * 2, (size_t)256 * 2048 * 2};
    EpiDown E{WSP(bf16_t, wsmap::XG), WSP(float, wsmap::SELS)};
    pg8::gemm_phase(F.lds, F.tid, 2048, 2048, S, E);
}

__device__ __forceinline__ void phase_norm2_router(const Frame& F, int l) {
    const int nrows = (l < DEPTH - 1) ? MROWS : NLAT;
    const float* wr = inp(F, I_WROUTER) + (size_t)l * D * NE;
    for (int r0 = (F.bid * 8 + F.wave) * 4; r0 < nrows; r0 += F.G * 8 * 4) {
        f32x4 h[4][4];
#pragma unroll
        for (int rr = 0; rr < 4; ++rr) { const int row = r0 + rr; f32x4 v[4];
            load_row16(stream_row(F, row), F.lane, v);
            const float* mod = WSP(float, wsmap::MOD) + ((size_t)l * 3 + row_modset(row)) * 6144;
            norm_mod_store(v, F.lane, inp(F, I_N2G) + (size_t)l * D, mod + 3 * 1024, mod + 4 * 1024, WSP(bf16_t, wsmap::HYB) + (size_t)row * HY_LD, &h[rr]); }
        float lg[64];
#pragma unroll
        for (int e = 0; e < 64; ++e) lg[e] = 0.f;
#pragma unroll
        for (int i = 0; i < 4; ++i)
#pragma unroll
            for (int j = 0; j < 4; ++j) { const float* wp = wr + (size_t)(i * 256 + F.lane * 4 + j) * NE;
#pragma unroll
                for (int q = 0; q < 4; ++q) { const f32x4 w = GLD(f32x4, wp + q * 4);
#pragma unroll
                    for (int rr = 0; rr < 4; ++rr) { const float hv = h[rr][i][j];
                        lg[rr * 16 + q * 4 + 0] += hv * w[0]; lg[rr * 16 + q * 4 + 1] += hv * w[1]; lg[rr * 16 + q * 4 + 2] += hv * w[2]; lg[rr * 16 + q * 4 + 3] += hv * w[3]; } } }
#pragma unroll
        for (int m = 32; m >= 1; m >>= 1) { const bool up = (F.lane & m) != 0;
#pragma unroll
            for (int i = 0; i < m; ++i) { const float keep = up ? lg[i + m] : lg[i], send = up ? lg[i] : lg[i + m]; lg[i] = keep + __shfl_xor(send, m); } }
        const float logit = lg[0];
        float mx = logit;
#pragma unroll
        for (int m = 8; m >= 1; m >>= 1) mx = fmaxf(mx, __shfl_xor(mx, m));
        const float ex = __expf(logit - mx); float den = ex;
#pragma unroll
        for (int m = 8; m >= 1; m >>= 1) den += __shfl_xor(den, m);
        { const int row = r0 + (F.lane >> 4), e = F.lane & 15; float* aff = WSP(float, wsmap::AFF); const float a = ex * __builtin_amdgcn_rcpf(den);
          if (row < NLAT) GST(float, aff + ((size_t)(row / SEQ) * NE + e) * SEQ + (row % SEQ)) = a;
          else { const int r = row - NLAT; GST(float, aff + (size_t)NB * NE * SEQ + ((size_t)(r / CTXL) * NE + e) * CTXL + (r % CTXL)) = a; } }
    }
    drain_moe_conv(F, l);
}
template <int N> __device__ __forceinline__ void topk_set(const Frame& F, const float* aff, int cap, int pair_base, int gp, int srcrow_base, int e) {
    LAS unsigned* val = (LAS unsigned*)F.lds;
    LAS unsigned* hist = val + N;
    LAS unsigned* misc = hist + 256;
    __syncthreads();
    { static_assert(N % 4 == 0, "vector loads"); constexpr int NV = N / 4, U = 8;
#pragma unroll 1
      for (int i0 = F.tid; i0 < NV; i0 += U * NTHREADS) { u32x4 t[U];
#pragma unroll
          for (int u = 0; u < U; ++u) { const int idx = i0 + u * NTHREADS; t[u] = GLD(u32x4, (const unsigned*)aff + 4 * (idx < NV ? idx : i0)); }
#pragma unroll
          for (int u = 0; u < U; ++u) { const int idx = i0 + u * NTHREADS; if (idx < NV) *(LAS u32x4*)(val + 4 * idx) = t[u]; } } }
    if (F.tid == 0) { int capv = cap;
#ifndef CPU_EMU
        asm volatile("" : "+s"(capv));
#endif
        misc[0] = 0u; misc[1] = (unsigned)capv; }
    __syncthreads();
    for (int pass = 0; pass < 4; ++pass) {
        const int shift = 24 - 8 * pass;
        if (F.tid < 256) hist[F.tid] = 0u;
        __syncthreads();
        const unsigned prefix = misc[0], pmask = pass == 0 ? 0u : (0xFFFFFFFFu << (shift + 8));
        for (int i = F.tid; i < N; i += NTHREADS) { const unsigned v = val[i]; if ((v & pmask) == prefix) (void)__hip_atomic_fetch_add(&hist[(v >> shift) & 255u], 1u, __ATOMIC_RELAXED, __HIP_MEMORY_SCOPE_WORKGROUP); }
        __syncthreads();
        if (F.tid < 64) {
            const unsigned rem = misc[1]; const int L = F.lane;
            const unsigned h0 = hist[4 * L], h1 = hist[4 * L + 1], h2 = hist[4 * L + 2], h3 = hist[4 * L + 3];
            unsigned suf = h0 + h1 + h2 + h3;
#pragma unroll
            for (int d = 1; d < 64; d <<= 1) { const unsigned y = __shfl_down(suf, d); if (L + d < 64) suf += y; }
            unsigned above = suf - (h0 + h1 + h2 + h3);
            const unsigned hv[4] = {h3, h2, h1, h0};
#pragma unroll
            for (int q = 0; q < 4; ++q) { const unsigned c = hv[q];
                if (above < rem && rem <= above + c) { misc[0] = prefix | ((unsigned)(4 * L + 3 - q) << shift); misc[1] = rem - above; }
                above += c; } }
        __syncthreads();
    }
    const unsigned thr = misc[0], need_eq = misc[1];
    constexpr int PER = N / NTHREADS > 0 ? N / NTHREADS : 1;
    const int i0 = F.tid * PER;
    unsigned cg = 0, ce = 0;
    if (i0 < N) for (int i = i0; i < i0 + PER; ++i) { const unsigned v = val[i]; cg += v > thr; ce += v == thr; }
    LAS unsigned* sg = misc + 2; LAS unsigned* se = sg + NTHREADS;
    { unsigned ig = cg, ie = ce;
#pragma unroll
      for (int d = 1; d < 64; d <<= 1) { const unsigned yg = __shfl_up(ig, d), ye = __shfl_up(ie, d); if (F.lane >= d) { ig += yg; ie += ye; } }
      if (F.lane == 63) { sg[F.wave] = ig; se[F.wave] = ie; }
      __syncthreads();
      unsigned og = 0, oe = 0;
#pragma unroll
      for (int q = 0; q < 8; ++q) { if (q < F.wave) { og += sg[q]; oe += se[q]; } }
      __syncthreads();
      sg[F.tid] = og + ig - cg; se[F.tid] = oe + ie - ce; }
    __syncthreads();
    int* seli = WSP(int, wsmap::SELI); float* sels = WSP(float, wsmap::SELS); int* slot = WSP(int, wsmap::SLOT);
    if (i0 < N) { unsigned ng = sg[F.tid], neq = se[F.tid];
        for (int i = i0; i < i0 + PER; ++i) { const unsigned v = val[i]; int pr = -1;
            if (v > thr) { const unsigned eqsel = neq < need_eq ? neq : need_eq; pr = pair_base + (int)(ng + eqsel); ++ng; }
            else if (v == thr) { if (neq < need_eq) { pr = pair_base + (int)(ng + neq); } ++neq; }
            slot[(size_t)(srcrow_base + i) * NE + e] = pr;
            if (pr >= 0) { seli[pr] = srcrow_base + i; sels[pr] = __uint_as_float(v); } } }
    for (int i = cap + F.tid; i < gp; i += NTHREADS) { seli[pair_base + i] = -1; sels[pair_base + i] = 0.f; }
}
__device__ __forceinline__ void phase_topk(const Frame& F, int l) {
    const int nset = (l < DEPTH - 1) ? 2 * NB * NE : NB * NE;
    for (int it = F.bid; it < nset; it += F.G) {
        if (it < NB * NE) { const int b = it / NE, e = it % NE;
            topk_set<SEQ>(F, WSP(float, wsmap::AFF) + (size_t)it * SEQ, CAP_LAT, it * GP_LAT, GP_LAT, b * SEQ, e); }
        else { const int g = it - NB * NE, b = g / NE, e = g % NE;
            topk_set<CTXL>(F, WSP(float, wsmap::AFF) + (size_t)NB * NE * SEQ + (size_t)g * CTXL, CAP_CTX, NPAIR_LAT + g * GP_CTX, GP_CTX, NLAT + b * CTXL, e); }
    }
    if (l + 1 < DEPTH) for (;;) { const int it = q_pull(F, 32 + l); if (it >= CONVA_ITEMS) break; conv_dense_item(F, l + 1, it); }
}
__device__ __forceinline__ void phase_gather(const Frame& F, int l) {
    const int npr = (l < DEPTH - 1) ? NPAIR : NPAIR_LAT;
    const int* seli = WSP(int, wsmap::SELI);
    for (int pr0 = (F.bid * 8 + F.wave) * 4; pr0 < npr; pr0 += F.G * 8 * 4) {
        int srcs[4]; u32x4 a[4], b[4];
#pragma unroll
        for (int q = 0; q < 4; ++q) srcs[q] = GLD(int, seli + pr0 + q);
#pragma unroll
        for (int q = 0; q < 4; ++q) { a[q] = (u32x4){0u, 0u, 0u, 0u}; b[q] = a[q];
            if (srcs[q] >= 0) { const bf16_t* sp = WSP(bf16_t, wsmap::HYB) + (size_t)srcs[q] * HY_LD; a[q] = GLD(u32x4, sp + F.lane * 8); b[q] = GLD(u32x4, sp + 512 + F.lane * 8); } }
#pragma unroll
        for (int q = 0; q < 4; ++q) { bf16_t* dp = WSP(bf16_t, wsmap::XG) + (size_t)(pr0 + q) * 1024; GST(u32x4, dp + F.lane * 8) = a[q]; GST(u32x4, dp + 512 + F.lane * 8) = b[q]; }
    }
}
__device__ __forceinline__ void phase_final(const Frame& F) {
    for (int r0 = (F.bid * 8 + F.wave) * 2; r0 < NLAT; r0 += F.G * 8 * 2) {
        f32x4 v[2][4];
#pragma unroll
        for (int rr = 0; rr < 2; ++rr) { const int row = r0 + rr; const float* xr = (const float*)(GAS float*)F.p->out + (size_t)row * D;
            load_row16(xr, F.lane, v[rr]); }
        moe_combine_rows2(F, r0, F.lane, WSP(float, wsmap::MOD) + ((size_t)(DEPTH - 1) * 3 + row_modset(r0)) * 6144 + 5 * 1024, WSP(float, wsmap::MOD) + ((size_t)(DEPTH - 1) * 3 + row_modset(r0 + 1)) * 6144 + 5 * 1024, v);
#pragma unroll
        for (int rr = 0; rr < 2; ++rr) { float* xr = (float*)(GAS float*)F.p->out + (size_t)(r0 + rr) * D;
            float ss = 0.f;
#pragma unroll
            for (int i = 0; i < 4; ++i) ss += v[rr][i][0] * v[rr][i][0] + v[rr][i][1] * v[rr][i][1] + v[rr][i][2] * v[rr][i][2] + v[rr][i][3] * v[rr][i][3];
            ss = wave_sum(ss);
            const float rstd = __builtin_amdgcn_rsqf(ss * (1.0f / D) + 1e-6f);
#pragma unroll
            for (int i = 0; i < 4; ++i) { const int c = i * 256 + F.lane * 4; GST(f32x4, xr + c) = v[rr][i] * rstd * GLD(f32x4, inp(F, I_FINALG) + c); } }
    }
}

__device__ __forceinline__ f32x4 mma_nt(const LAS bf16_t* A, int lda, const LAS bf16_t* B, int ldb, int K, f32x4 acc, int lane, int ra = -1, int rb = -1) {
    const int gm = (K >> 3) - 1, kg = lane >> 4;
    const LAS bf16_t* ap = A + (lane & 15) * lda; const LAS bf16_t* bp = B + (lane & 15) * ldb;
#pragma unroll 2
    for (int kk = 0; kk < K; kk += 32) { const int g = (kk >> 3) + kg;
        const int oa = ra < 0 ? g * 8 : ((g + ra) & gm) * 8, ob = rb < 0 ? g * 8 : ((g + rb) & gm) * 8;
        acc = __builtin_amdgcn_mfma_f32_16x16x32_bf16(*(const LAS bf16x8*)(ap + oa), *(const LAS bf16x8*)(bp + ob), acc, 0, 0, 0); }
    return acc;
}
template <int G, int RS> __device__ __forceinline__ int tphys(int r, int t) { return ((((t >> 3) + (r >> RS)) & (G - 1)) << 3) | (t & 7); }
__device__ __forceinline__ void unpack8(const u32x4 w, float (&v)[8]) { v[0] = bflo(w.x); v[1] = bfhi(w.x); v[2] = bflo(w.y); v[3] = bfhi(w.y); v[4] = bflo(w.z); v[5] = bfhi(w.z); v[6] = bflo(w.w); v[7] = bfhi(w.w); }
__device__ __forceinline__ u32x4 ldp8(const bf16_t* P, int row, int col) { return row < 0 ? (u32x4){0u, 0u, 0u, 0u} : GLD(u32x4, P + (size_t)row * PCOLS + col); }
constexpr int NSC_C = CTXL / SC, NSC_L = SEQ / SC;
__device__ __forceinline__ int sc_mirror(int c) { return c < NSC_C ? (NSC_C - 1 - c) : NSC_C + (NSC_L - 1 - (c - NSC_C)); }
__device__ __forceinline__ void copy_g2l(const Frame& F, const bf16_t* g, LAS float* s, int n) {
#pragma unroll 4
    for (int i = F.tid * 8; i < n; i += NTHREADS * 8) { float v[8]; unpack8(GLD(u32x4, g + i), v);
        *(LAS f32x4*)(s + i) = (f32x4){v[0], v[1], v[2], v[3]}; *(LAS f32x4*)(s + i + 4) = (f32x4){v[4], v[5], v[6], v[7]}; }
}
__device__ __forceinline__ void copy_l2g(const Frame& F, const LAS float* s, bf16_t* g, int n) {
#pragma unroll 1
    for (int i = F.tid * 8; i < n; i += NTHREADS * 8) { const f32x4 a = *(const LAS f32x4*)(s + i), b = *(const LAS f32x4*)(s + i + 4);
        u32x4 w; w.x = cvt_pk_bf16(a[0], a[1]); w.y = cvt_pk_bf16(a[2], a[3]); w.z = cvt_pk_bf16(b[0], b[1]); w.w = cvt_pk_bf16(b[2], b[3]);
        GST(u32x4, g + i) = w; }
}
__device__ __forceinline__ float* wg_scratch(const Frame& F) { return (float*)(F.ws + wsmap::WSCR + (size_t)F.bid * wsmap::WSCR_PER); }

namespace hg { constexpr int T = 32, QF = 0, KF = 16896, BF = 33792, VT = 50688, KT = 60928, QD = 71168, ATT = 79872, ST = 82432, OB = 117248, BT = 134144, BSC = 134656, SEG = 135168, END = 137216; }
template <bool OUT> __device__ __forceinline__ void hg_pass(const Frame& F, int l, int b, int dir, int head, int scidx, f32x4 (&sacc)[8], bool second) {
    LAS unsigned char* L = F.lds; const int tid = F.tid, lane = F.lane, w = F.wave;
    LAS float* qf = (LAS float*)(L + hg::QF); LAS float* kf = (LAS float*)(L + hg::KF); LAS float* bfp = (LAS float*)(L + hg::BF);
    LAS bf16_t* vT = (LAS bf16_t*)(L + hg::VT); LAS bf16_t* kT = (LAS bf16_t*)(L + hg::KT); LAS bf16_t* qd = (LAS bf16_t*)(L + hg::QD);
    LAS bf16_t* att = (LAS bf16_t*)(L + hg::ATT); LAS bf16_t* STb = (LAS bf16_t*)(L + hg::ST); LAS float* ob = (LAS float*)(L + hg::OB);
    LAS float* btot = (LAS float*)(L + hg::BT); LAS float* bsc = (LAS float*)(L + hg::BSC);
    const bf16_t* P = WSP(bf16_t, wsmap::P); const float* lbp = WSP(float, wsmap::LB) + l * 512 + head * 128;
    float* oscr = wg_scratch(F);
    float lbv[8];
#pragma unroll
    for (int j = 0; j < 8; ++j) lbv[j] = GLD(float, lbp + (tid & 15) * 8 + j);
    u32x4 rq = (u32x4){0u, 0u, 0u, 0u}, rf, rv;
    { const bf16_t* pr = P + (size_t)scan_row(b, dir, scidx * SC + (tid >> 4), true) * PCOLS + head * 128 + (tid & 15) * 8;
      if (OUT) rq = GLD(u32x4, pr + PC_HG_Q);
      rf = GLD(u32x4, pr + (dir ? PC_HG_FB : PC_HG_FF)); rv = GLD(u32x4, pr + PC_HG_I); }
#pragma unroll 1
    for (int sub = 0; sub < SC / hg::T; ++sub) {
        const int j0 = scidx * SC + sub * hg::T;
        { const int t = tid >> 4, c8 = (tid & 15) * 8;
          float q[8], fp[8], vv[8];
          if (OUT) unpack8(rq, q);
          unpack8(rf, fp);
          const u32x4 vraw = rv;
          if (sub + 1 < SC / hg::T) { const bf16_t* pr = P + (size_t)scan_row(b, dir, j0 + hg::T + t, true) * PCOLS + head * 128 + c8;
              if (OUT) rq = GLD(u32x4, pr + PC_HG_Q);
              rf = GLD(u32x4, pr + (dir ? PC_HG_FB : PC_HG_FF)); rv = GLD(u32x4, pr + PC_HG_I); }
#pragma unroll
          for (int j = 0; j < 8; ++j) { const float lb = lbv[j], sg = sigmoidf_(fp[j]);
              if (OUT) qf[t * 132 + c8 + j] = siluf_(q[j]);
              kf[t * 132 + c8 + j] = (1.0f - lb) * (1.0f - sg);
              bfp[t * 132 + c8 + j] = __logf(fmaxf(lb, 1e-30f) + (1.0f - lb) * sg); }
          const unsigned vw[4] = {vraw.x, vraw.y, vraw.z, vraw.w};
#pragma unroll
          for (int j = 0; j < 8; ++j) vT[(c8 + j) * 40 + tphys<4, 3>(c8 + j, t)] = (bf16_t)((vw[j >> 1] >> ((j & 1) * 16)) & 0xFFFFu); }
        __syncthreads();
        u32x4 graw = (u32x4){0u, 0u, 0u, 0u}; f32x4 pk0 = (f32x4){0.f, 0.f, 0.f, 0.f}, pk1 = pk0;
        if (OUT && second) { const int t = tid >> 4, c8 = (tid & 15) * 8; const int jl = sub * hg::T + t, tl = dir ? (SC - 1 - jl) : jl;
            const float* sp = oscr + (size_t)tl * 128 + c8; pk0 = GLD(f32x4, sp); pk1 = GLD(f32x4, sp + 4);
            graw = GLD(u32x4, P + (size_t)scan_row(b, dir, j0 + t, true) * PCOLS + PC_HG_G + head * 128 + c8); }
        { LAS float* seg = (LAS float*)(L + hg::SEG); const int k = tid & 127, sg = tid >> 7;
          float v[8]; float run = 0.f;
#pragma unroll
          for (int i = 0; i < 8; ++i) { run += bfp[(sg * 8 + i) * 132 + k]; v[i] = run; }
          seg[sg * 128 + k] = run;
          __syncthreads();
          float off = 0.f;
#pragma unroll
          for (int s2 = 0; s2 < 3; ++s2) off += (s2 < sg) ? seg[s2 * 128 + k] : 0.f;
#pragma unroll
          for (int i = 0; i < 8; ++i) bfp[(sg * 8 + i) * 132 + k] = v[i] + off;
          if (sg == 3) { btot[k] = run + off; if (!OUT) bsc[k] += run + off; } }
        __syncthreads();
        { const int t = tid >> 4, c8 = (tid & 15) * 8;
#pragma unroll
          for (int j = 0; j < 8; ++j) { const int k = c8 + j; const float bb = bfp[t * 132 + k];
              if (OUT) qd[t * 136 + k] = f2bf1(qf[t * 132 + k] * __expf(bb));
              kT[k * 40 + tphys<4, 3>(k, t)] = f2bf1(kf[t * 132 + k] * __expf(btot[k] - bb)); }
          }
        if (OUT) {
            LAS float* pt = ob;
#pragma unroll 1
            for (int u = w; u < 12; u += 8) { const int blk = u >> 2, ks = u & 3;
                const int t0 = blk == 0 ? 0 : 16, s0 = blk == 1 ? 16 : 0, rr = blk == 0 ? 7 : (blk == 1 ? 23 : 15);
                const int row = lane & 15, k0 = ks * 32 + (lane >> 4) * 8;
                bf16x8 af, bfr;
#pragma unroll
                for (int hh = 0; hh < 2; ++hh) { const int k = k0 + hh * 4;
                    const f32x4 rf = *(const LAS f32x4*)(bfp + rr * 132 + k);
                    const f32x4 qa = *(const LAS f32x4*)(qf + (t0 + row) * 132 + k), ba = *(const LAS f32x4*)(bfp + (t0 + row) * 132 + k);
                    const f32x4 kb2 = *(const LAS f32x4*)(kf + (s0 + row) * 132 + k), bb2 = *(const LAS f32x4*)(bfp + (s0 + row) * 132 + k);
#pragma unroll
                    for (int j = 0; j < 4; ++j) { af[hh * 4 + j] = (short)f2bf1(qa[j] * __expf(fminf(ba[j] - rf[j], 80.f))); bfr[hh * 4 + j] = (short)f2bf1(kb2[j] * __expf(fminf(rf[j] - bb2[j], 80.f))); } }
                const f32x4 pa = __builtin_amdgcn_mfma_f32_16x16x32_bf16(af, bfr, (f32x4){0.f, 0.f, 0.f, 0.f}, 0, 0, 0);
#pragma unroll
                for (int r = 0; r < 4; ++r) pt[u * 256 + ((lane >> 4) * 4 + r) * 16 + (lane & 15)] = pa[r]; }
            __syncthreads();
#pragma unroll
            for (int i2 = 0; i2 < 2; ++i2) { const int i = tid + i2 * NTHREADS, blk = i >> 8, e = i & 255, row = e >> 4, col = e & 15;
                if (blk < 3) { const int t = (blk == 0 ? 0 : 16) + row, s = (blk == 1 ? 16 : 0) + col;
                    const float a = (pt[(blk * 4 + 0) * 256 + e] + pt[(blk * 4 + 1) * 256 + e]) + (pt[(blk * 4 + 2) * 256 + e] + pt[(blk * 4 + 3) * 256 + e]);
                    att[t * 40 + s] = f2bf1(s <= t ? a : 0.f); }
                else att[row * 40 + 16 + col] = (bf16_t)0; } }
        __syncthreads();
        if (OUT) {
#pragma unroll
            for (int tt = 0; tt < 2; ++tt) { f32x4 a = (f32x4){0.f, 0.f, 0.f, 0.f};
                a = mma_nt(att + tt * 16 * 40, 40, vT + w * 16 * 40, 40, 32, a, lane, -1, (w * 16 + (lane & 15)) >> 3);
                a = mma_nt(qd + tt * 16 * 136, 136, STb + w * 16 * 136, 136, 128, a, lane);
#pragma unroll
                for (int r = 0; r < 4; ++r) ob[(tt * 16 + (lane >> 4) * 4 + r) * 132 + w * 16 + (lane & 15)] = a[r]; } }
#pragma unroll
        for (int kt = 0; kt < 8; ++kt) { __builtin_amdgcn_sched_barrier(0); const float e = __expf(btot[kt * 16 + (lane & 15)]);
            f32x4 a = sacc[kt] * e; a = mma_nt(vT + w * 16 * 40, 40, kT + kt * 16 * 40, 40, 32, a, lane, (w * 16 + (lane & 15)) >> 3, (kt * 16 + (lane & 15)) >> 3); sacc[kt] = a;
            if (OUT) {
#pragma unroll
                for (int r = 0; r < 4; ++r) STb[(w * 16 + (lane >> 4) * 4 + r) * 136 + kt * 16 + (lane & 15)] = f2bf1(a[r]); } }
        __syncthreads();
        if (OUT) { const int t = tid >> 4, c8 = (tid & 15) * 8; const int jl = sub * hg::T + t, tl = dir ? (SC - 1 - jl) : jl;
            float o[8];
#pragma unroll
            for (int j = 0; j < 8; ++j) o[j] = ob[t * 132 + c8 + j];
            float* sp = oscr + (size_t)tl * 128 + c8;
            if (!second) { GST(f32x4, sp) = (f32x4){o[0], o[1], o[2], o[3]}; GST(f32x4, sp + 4) = (f32x4){o[4], o[5], o[6], o[7]}; }
            else { const f32x4 p0 = pk0, p1 = pk1;
                o[0] += p0[0]; o[1] += p0[1]; o[2] += p0[2]; o[3] += p0[3]; o[4] += p1[0]; o[5] += p1[1]; o[6] += p1[2]; o[7] += p1[3];
                float ss = 0.f;
#pragma unroll
                for (int j = 0; j < 8; ++j) ss += o[j] * o[j];
                ss += __shfl_xor(ss, 1); ss += __shfl_xor(ss, 2); ss += __shfl_xor(ss, 4); ss += __shfl_xor(ss, 8);
                const float rstd = __builtin_amdgcn_rsqf(ss * (1.0f / 128.0f) + 1e-6f);
                const int row = scan_row(b, dir, j0 + t, true); float g[8];
                unpack8(graw, g);
                const float* ng = inp(F, I_HG_NG) + (size_t)l * 512 + head * 128 + c8;
#pragma unroll
                for (int j = 0; j < 8; ++j) o[j] = o[j] * rstd * ng[j] * sigmoidf_(g[j]);
                u32x4 wv; wv.x = cvt_pk_bf16(o[0], o[1]); wv.y = cvt_pk_bf16(o[2], o[3]); wv.z = cvt_pk_bf16(o[4], o[5]); wv.w = cvt_pk_bf16(o[6], o[7]);
                GST(u32x4, WSP(bf16_t, wsmap::HYB) + (size_t)row * HY_LD + 1024 + 3 * 512 + head * 128 + c8) = wv; } }
    }
}
__device__ __forceinline__ void hg_state_load(const Frame& F, const bf16_t* st, f32x4 (&sacc)[8]) {
    LAS float* stg = (LAS float*)F.lds; LAS bf16_t* STb = (LAS bf16_t*)(F.lds + hg::ST); const int lane = F.lane, w = F.wave;
    copy_g2l(F, st, stg, 16384);
    __syncthreads();
    const LAS float* sp = stg + (w * 16 + (lane >> 4) * 4) * 128 + (lane & 15); LAS bf16_t* bp = STb + (w * 16 + (lane >> 4) * 4) * 136 + (lane & 15);
#pragma unroll
    for (int kt = 0; kt < 8; ++kt)
#pragma unroll
        for (int r = 0; r < 4; ++r) { const float x = sp[r * 128 + kt * 16]; sacc[kt][r] = x; bp[r * 136 + kt * 16] = f2bf1(x); }
    __syncthreads();
}
__device__ __forceinline__ void hg_m1_item(const Frame& F, int l, int it) {
    const int chain = it / NSC, sc = it % NSC, head = chain & 3, dir = (chain >> 2) & 1, b = chain >> 3;
    f32x4 sacc[8];
#pragma unroll
    for (int kt = 0; kt < 8; ++kt) sacc[kt] = (f32x4){0.f, 0.f, 0.f, 0.f};
    LAS float* bsc = (LAS float*)(F.lds + hg::BSC);
    __syncthreads();
    if (F.tid < 128) bsc[F.tid] = 0.f;
    __syncthreads();
    hg_pass<false>(F, l, b, dir, head, sc, sacc, false);
    { LAS float* stg = (LAS float*)F.lds; LAS float* sp = stg + (F.wave * 16 + (F.lane >> 4) * 4) * 128 + (F.lane & 15);
#pragma unroll
      for (int kt = 0; kt < 8; ++kt)
#pragma unroll
          for (int r = 0; r < 4; ++r) sp[r * 128 + kt * 16] = sacc[kt][r];
      __syncthreads();
      copy_l2g(F, stg, WSP(bf16_t, wsmap::ST_HG) + (size_t)it * 16384, 16384); }
    if (F.tid < 128) WSP(float, wsmap::DEC_HG)[(size_t)it * 128 + F.tid] = __expf(bsc[F.tid]);
}
__device__ __forceinline__ void hg_m3_item(const Frame& F, int l, int it) {
    const int c = it % NSC, bh = it / NSC, head = bh & 3, b = bh >> 2;
    f32x4 sacc[8];
#pragma unroll
    for (int dir = 0; dir < 2; ++dir) { const int scidx = dir ? sc_mirror(c) : c; const int chain = (b * 2 + dir) * 4 + head;
        __syncthreads();
        hg_state_load(F, WSP(bf16_t, wsmap::ST_HG) + ((size_t)chain * NSC + scidx) * 16384, sacc);
        hg_pass<true>(F, l, b, dir, head, scidx, sacc, dir == 1); }
}

namespace ml { constexpr int T = 64, QB = 0, KB = 17408, VT = 34816, WKT = 55552, WM = 73984, CB = 83200, SCAL = 122368, CWL = 124416, END = 128512;
    constexpr int BC = 0, LI = 64, DN = 128, LF = 192; }
template <bool OUT> __device__ __forceinline__ void ml_pass(const Frame& F, int l, int b, int dir, int head, int scidx, f32x4 (&cacc)[9], float& dec_log, bool second) {
    LAS unsigned char* L = F.lds; const int tid = F.tid, lane = F.lane, w = F.wave;
    LAS bf16_t* qb = (LAS bf16_t*)(L + ml::QB); LAS bf16_t* kb = (LAS bf16_t*)(L + ml::KB); LAS bf16_t* vT = (LAS bf16_t*)(L + ml::VT);
    LAS bf16_t* wkT = (LAS bf16_t*)(L + ml::WKT); LAS bf16_t* Wm = (LAS bf16_t*)(L + ml::WM); LAS bf16_t* Cb = (LAS bf16_t*)(L + ml::CB);
    LAS float* sc = (LAS float*)(L + ml::SCAL); LAS float* ob = (LAS float*)(L + ml::QB);
    const bf16_t* P = WSP(bf16_t, wsmap::P); const float* G32 = WSP(float, wsmap::G32);
    const float* cw = inp(F, I_ML_CW) + (size_t)l * 3 * 1024; const float* cb = inp(F, I_ML_CB) + (size_t)l * 1024;
    const float ib = inp(F, I_ML_IB)[(l * 2 + dir) * 4 + head], fb = inp(F, I_ML_FB)[(l * 2 + dir) * 4 + head];
    float* oscr = wg_scratch(F);
    bf16_t* qkc = (bf16_t*)((unsigned char*)oscr + 131072);
    LAS float* cwl = (LAS float*)(L + ml::CWL);
    { const int j = tid >> 8, qc = tid & 255, ch = (qc >> 7) * 512 + head * 128 + (qc & 127);
      cwl[j * 256 + qc] = cw[j * 1024 + ch]; cwl[(j + 2) * 256 + qc] = j ? cb[ch] : cw[2048 + ch]; }
    __syncthreads();
    u32x4 rq[2][2], rh[2][2], rv[2]; float gi = 0.f, gf = 0.f;
#define ML_LOAD(J0) do { const int t_ = tid >> 3, c16_ = (tid & 7) * 16; const int row_ = scan_row(b, dir, (J0) + t_, false); \
        const int hrow_ = lane < 8 ? (dir ? row_next(row_) : row_prev(row_)) : (lane >= 56 ? (dir ? row_prev(row_) : row_next(row_)) : -1); \
        _Pragma("unroll") for (int hh_ = 0; hh_ < 2; ++hh_) { _Pragma("unroll") for (int qk_ = 0; qk_ < 2; ++qk_) { const int col_ = (qk_ ? PC_ML_K : PC_ML_Q) + head * 128 + c16_ + hh_ * 8; \
                if (OUT && second) rq[hh_][qk_] = GLD(u32x4, qkc + (size_t)(SC - 1 - ((J0) - scidx * SC + t_)) * 256 + qk_ * 128 + c16_ + hh_ * 8); \
                else if (OUT || qk_) { rq[hh_][qk_] = ldp8(P, row_, col_); rh[hh_][qk_] = ldp8(P, hrow_, col_); } } \
            rv[hh_] = GLD(u32x4, P + (size_t)row_ * PCOLS + PC_ML_V + head * 128 + c16_ + hh_ * 8); } \
        if (tid < 64) { const int r2_ = scan_row(b, dir, (J0) + tid, false); gi = GLD(float, G32 + (size_t)r2_ * 32 + 16 + dir * 4 + head); gf = GLD(float, G32 + (size_t)r2_ * 32 + 24 + dir * 4 + head); } } while (0)
    ML_LOAD(scidx * SC);
#pragma unroll 1
    for (int sub = 0; sub < SC / ml::T; ++sub) {
        const int j0 = scidx * SC + sub * ml::T;
        { const int t = tid >> 3, c16 = (tid & 7) * 16;
#pragma unroll
          for (int hh = 0; hh < 2; ++hh) { const int c8 = c16 + hh * 8;
#pragma unroll
              for (int qk = OUT ? 0 : 1; qk < 2; ++qk) { __builtin_amdgcn_sched_barrier(0);
                  if (OUT && second) { *(LAS u32x4*)((qk ? kb : qb) + t * 136 + c8) = rq[hh][qk]; continue; }
                  const u32x4 cur = rq[hh][qk], hal = rh[hh][qk]; u32x4 lo, hi;
                  lo.x = __shfl_up(cur.x, 8); lo.y = __shfl_up(cur.y, 8); lo.z = __shfl_up(cur.z, 8); lo.w = __shfl_up(cur.w, 8);
                  hi.x = __shfl_down(cur.x, 8); hi.y = __shfl_down(cur.y, 8); hi.z = __shfl_down(cur.z, 8); hi.w = __shfl_down(cur.w, 8);
                  if (lane < 8) lo = hal; if (lane >= 56) hi = hal;
                  float xm[8], x0[8], xp[8]; unpack8(dir ? hi : lo, xm); unpack8(cur, x0); unpack8(dir ? lo : hi, xp);
                  float o[8];
#pragma unroll
                  for (int j = 0; j < 8; ++j) { const int cl = qk * 128 + c8 + j; const float y = cwl[cl] * xm[j] + cwl[256 + cl] * x0[j] + cwl[512 + cl] * xp[j] + cwl[768 + cl]; o[j] = siluf_(y) * (qk ? 0.08838834764831845f : 1.0f); }
                  u32x4 wv; wv.x = cvt_pk_bf16(o[0], o[1]); wv.y = cvt_pk_bf16(o[2], o[3]); wv.z = cvt_pk_bf16(o[4], o[5]); wv.w = cvt_pk_bf16(o[6], o[7]);
                  *(LAS u32x4*)((qk ? kb : qb) + t * 136 + c8) = wv;
                  if (OUT) GST(u32x4, qkc + (size_t)(sub * ml::T + t) * 256 + qk * 128 + c8) = wv; }
              const unsigned vw[4] = {rv[hh].x, rv[hh].y, rv[hh].z, rv[hh].w};
#pragma unroll
              for (int j = 0; j < 8; ++j) vT[(c8 + j) * 72 + tphys<8, 4>(c8 + j, t)] = (bf16_t)((vw[j >> 1] >> ((j & 1) * 16)) & 0xFFFFu); }
          if (tid < 64) { sc[ml::LI + tid] = gi + ib; sc[ml::LF + tid] = logsigmoidf_(gf + fb); } }
        __syncthreads();
        if (sub + 1 < SC / ml::T) ML_LOAD(j0 + ml::T);
        u32x4 oraw[2]; f32x4 pk[4];
        oraw[0] = oraw[1] = (u32x4){0u, 0u, 0u, 0u}; pk[0] = pk[1] = pk[2] = pk[3] = (f32x4){0.f, 0.f, 0.f, 0.f};
        if (OUT && second) { const int t = tid >> 3, c16 = (tid & 7) * 16; const int jl = sub * ml::T + t, tl = dir ? (SC - 1 - jl) : jl;
            const float* sp = oscr + (size_t)tl * 128 + c16;
#pragma unroll
            for (int j = 0; j < 4; ++j) pk[j] = GLD(f32x4, sp + 4 * j);
            const bf16_t* gp = P + (size_t)scan_row(b, dir, j0 + t, false) * PCOLS + PC_ML_O + head * 128 + c16; oraw[0] = GLD(u32x4, gp); oraw[1] = GLD(u32x4, gp + 8); }
        { float x = sc[ml::LF + lane];
            x = wave_scan_incl(x);
            sc[ml::BC + lane] = x; WAVE_LDS_SYNC(); }
        const float btot = sc[ml::BC + 63];
        { const int s = tid >> 3, c16 = (tid & 7) * 16; const float ws = __expf(btot - sc[ml::BC + s] + sc[ml::LI + s]);
#pragma unroll
          for (int j = 0; j < 16; ++j) wkT[(c16 + j) * 72 + tphys<8, 4>(c16 + j, s)] = f2bf1(bf2f(kb[s * 136 + c16 + j]) * ws); }
        if (OUT) {
#pragma unroll
            for (int q = 0; q < 2; ++q) { const int idx = w * 2 + q, tt = idx >> 2, ss = idx & 3;
                f32x4 a = (f32x4){0.f, 0.f, 0.f, 0.f};
                if (ss <= tt) a = mma_nt(qb + tt * 16 * 136, 136, kb + ss * 16 * 136, 136, 128, a, lane);
                const int s = ss * 16 + (lane & 15); const float cs = sc[ml::LI + s] - sc[ml::BC + s];
#pragma unroll
                for (int r = 0; r < 4; ++r) { const int t = tt * 16 + (lane >> 4) * 4 + r;
                    Wm[t * 72 + s] = f2bf1(s <= t ? a[r] * __expf(sc[ml::BC + t] + cs) : 0.f); } } }
        __syncthreads();
        f32x4 res[5];
        if (OUT) { const int tt = w & 3;
#pragma unroll
            for (int i = 0; i < 5; ++i) { __builtin_amdgcn_sched_barrier(0); const int vt = (w >> 2) + 2 * i; res[i] = (f32x4){0.f, 0.f, 0.f, 0.f};
                if (vt < 9) { f32x4 a1 = mma_nt(Wm + tt * 16 * 72, 72, vT + vt * 16 * 72, 72, 64, (f32x4){0.f, 0.f, 0.f, 0.f}, lane, -1, vt);
                    f32x4 a2 = mma_nt(qb + tt * 16 * 136, 136, Cb + vt * 16 * 136, 136, 128, (f32x4){0.f, 0.f, 0.f, 0.f}, lane);
#pragma unroll
                    for (int r = 0; r < 4; ++r) { const int t = tt * 16 + (lane >> 4) * 4 + r; res[i][r] = a1[r] + __expf(sc[ml::BC + t]) * a2[r]; }
                    if (vt == 8 && (lane & 15) == 0) {
#pragma unroll
                        for (int r = 0; r < 4; ++r) sc[ml::DN + tt * 16 + (lane >> 4) * 4 + r] = res[i][r]; } } } }
        __syncthreads();
        if (OUT) { const int tt = w & 3;
#pragma unroll
            for (int i = 0; i < 5; ++i) { const int vt = (w >> 2) + 2 * i;
                if (vt < 8) {
#pragma unroll
                    for (int r = 0; r < 4; ++r) { const int t = tt * 16 + (lane >> 4) * 4 + r; ob[t * 132 + vt * 16 + (lane & 15)] = res[i][r]; } } } }
        { const float eb = __expf(btot);
#pragma unroll
          for (int vt = 0; vt < 9; ++vt) { __builtin_amdgcn_sched_barrier(0); f32x4 a = cacc[vt] * eb; a = mma_nt(vT + vt * 16 * 72, 72, wkT + w * 16 * 72, 72, 64, a, lane, vt, w); cacc[vt] = a;
              if (OUT) {
#pragma unroll
                  for (int r = 0; r < 4; ++r) Cb[(vt * 16 + (lane >> 4) * 4 + r) * 136 + w * 16 + (lane & 15)] = f2bf1(a[r]); } } }
        dec_log += btot;
        __syncthreads();
        if (OUT) { const int t = tid >> 3, c16 = (tid & 7) * 16; const int jl = sub * ml::T + t, tl = dir ? (SC - 1 - jl) : jl;
            float o[16];
            { const float dinv = __builtin_amdgcn_rcpf(fmaxf(fabsf(sc[ml::DN + t]), 1.0f));
#pragma unroll
              for (int j = 0; j < 16; ++j) o[j] = ob[t * 132 + c16 + j] * dinv; }
            float* sp = oscr + (size_t)tl * 128 + c16;
            if (!second) {
#pragma unroll
                for (int j = 0; j < 16; j += 4) GST(f32x4, sp + j) = (f32x4){o[j], o[j + 1], o[j + 2], o[j + 3]}; }
            else {
#pragma unroll
                for (int j = 0; j < 16; j += 4) { const f32x4 pv = pk[j >> 2]; o[j] += pv[0]; o[j + 1] += pv[1]; o[j + 2] += pv[2]; o[j + 3] += pv[3]; }
                float ss = 0.f;
#pragma unroll
                for (int j = 0; j < 16; ++j) ss += o[j] * o[j];
                ss += __shfl_xor(ss, 1); ss += __shfl_xor(ss, 2); ss += __shfl_xor(ss, 4);
                const float rstd = __builtin_amdgcn_rsqf(ss * (1.0f / 128.0f) + 1e-6f);
                const int row = scan_row(b, dir, j0 + t, false);
                const float* ng = inp(F, I_ML_NG) + (size_t)l * 512 + head * 128 + c16;
#pragma unroll
                for (int hh = 0; hh < 2; ++hh) { float g[8]; unpack8(oraw[hh], g);
                    float y[8];
#pragma unroll
                    for (int j = 0; j < 8; ++j) y[j] = o[hh * 8 + j] * rstd * ng[hh * 8 + j] * sigmoidf_(g[j]);
                    u32x4 wv; wv.x = cvt_pk_bf16(y[0], y[1]); wv.y = cvt_pk_bf16(y[2], y[3]); wv.z = cvt_pk_bf16(y[4], y[5]); wv.w = cvt_pk_bf16(y[6], y[7]);
                    GST(u32x4, WSP(bf16_t, wsmap::HYB) + (size_t)row * HY_LD + 1024 + 2 * 512 + head * 128 + c16 + hh * 8) = wv; } } }
        __syncthreads();
    }
}
__device__ __forceinline__ void ml_vt_ones(const Frame& F) {
    LAS bf16_t* vT = (LAS bf16_t*)(F.lds + ml::VT);
    for (int i = F.tid; i < 16 * 72; i += NTHREADS) vT[128 * 72 + i] = (bf16_t)((i < 72) ? 0x3F80u : 0u);
}
__device__ __forceinline__ void ml_m1_item(const Frame& F, int l, int it) {
    const int chain = it / NSC, sc = it % NSC, head = chain & 3, dir = (chain >> 2) & 1, b = chain >> 3;
    f32x4 cacc[9];
#pragma unroll
    for (int vt = 0; vt < 9; ++vt) cacc[vt] = (f32x4){0.f, 0.f, 0.f, 0.f};
    __syncthreads(); ml_vt_ones(F); __syncthreads();
    float dl = 0.f;
    ml_pass<false>(F, l, b, dir, head, sc, cacc, dl, false);
    { LAS float* stg = (LAS float*)F.lds; LAS float* sp = stg + ((F.lane >> 4) * 4) * 128 + F.wave * 16 + (F.lane & 15);
#pragma unroll
      for (int vt = 0; vt < 9; ++vt)
#pragma unroll
          for (int r = 0; r < 4; ++r) sp[(vt * 16 + r) * 128] = cacc[vt][r];
      __syncthreads();
      copy_l2g(F, stg, WSP(bf16_t, wsmap::ST_ML) + (size_t)it * 144 * 128, 144 * 128); }
    if (F.tid == 0) WSP(float, wsmap::DEC_ML)[it] = __expf(dl);
}
__device__ __forceinline__ void ml_m3_item(const Frame& F, int l, int it) {
    const int c = it % NSC, bh = it / NSC, head = bh & 3, b = bh >> 2;
    f32x4 cacc[9];
#pragma unroll
    for (int dir = 0; dir < 2; ++dir) { const int scidx = dir ? sc_mirror(c) : c; const int chain = (b * 2 + dir) * 4 + head;
        LAS float* stg = (LAS float*)F.lds; LAS bf16_t* Cb = (LAS bf16_t*)(F.lds + ml::CB);
        __syncthreads();
        copy_g2l(F, WSP(bf16_t, wsmap::ST_ML) + ((size_t)chain * NSC + scidx) * 144 * 128, stg, 144 * 128);
        __syncthreads();
        { const LAS float* sp = stg + ((F.lane >> 4) * 4) * 128 + F.wave * 16 + (F.lane & 15); LAS bf16_t* bp = Cb + ((F.lane >> 4) * 4) * 136 + F.wave * 16 + (F.lane & 15);
#pragma unroll
          for (int vt = 0; vt < 9; ++vt)
#pragma unroll
              for (int r = 0; r < 4; ++r) { const float x = sp[(vt * 16 + r) * 128]; cacc[vt][r] = x; bp[(vt * 16 + r) * 136] = f2bf1(x); } }
        __syncthreads();
        ml_vt_ones(F);
        __syncthreads();
        float dl = 0.f;
        ml_pass<true>(F, l, b, dir, head, scidx, cacc, dl, dir == 1); }
}

namespace sd { constexpr int T = 64, CM = 0, BM = 9216, XT = 18432, WXT = 27648, BTR = 36864, SCM = 46080, HB = 55296, OB = 64512, SCAL = 81920, CWL = 83968, END = 87040;
    constexpr int ACS = 0, DT = 64, DA = 128; }
template <bool OUT> __device__ __forceinline__ void sd_pass(const Frame& F, int l, int b, int dir, int head, int scidx, f32x4 (&hacc)[2], float& dec_log, bool second) {
    LAS unsigned char* L = F.lds; const int tid = F.tid, lane = F.lane, w = F.wave, grp = head >> 2;
    LAS bf16_t* Cm = (LAS bf16_t*)(L + sd::CM); LAS bf16_t* Bm = (LAS bf16_t*)(L + sd::BM); LAS bf16_t* xT = (LAS bf16_t*)(L + sd::XT); LAS bf16_t* wxT = (LAS bf16_t*)(L + sd::WXT);
    LAS bf16_t* BT = (LAS bf16_t*)(L + sd::BTR); LAS bf16_t* Scm = (LAS bf16_t*)(L + sd::SCM); LAS bf16_t* Hb = (LAS bf16_t*)(L + sd::HB); LAS float* ob = (LAS float*)(L + sd::OB);
    LAS float* sc = (LAS float*)(L + sd::SCAL);
    const bf16_t* P = WSP(bf16_t, wsmap::P); const float* G32 = WSP(float, wsmap::G32);
    const float* cw = inp(F, I_SSD_CW) + (size_t)l * 3 * 768; const float* cb = inp(F, I_SSD_CB) + (size_t)l * 768;
    const float dtb = inp(F, I_SSD_DTB)[(l * 2 + dir) * 8 + head], Aneg = -__expf(inp(F, I_SSD_ALOG)[(l * 2 + dir) * 8 + head]);
    float* oscr = wg_scratch(F);
    bf16_t* xbc = (bf16_t*)((unsigned char*)oscr + 131072);
    LAS float* cwl = (LAS float*)(L + sd::CWL);
    for (int i = tid; i < 768; i += NTHREADS) { const int j = i / 192, qc = i % 192, ch = (qc < 64 ? head * 64 + qc : qc < 128 ? 512 + grp * 64 + (qc - 64) : 640 + grp * 64 + (qc - 128));
        cwl[i] = j < 3 ? cw[j * 768 + ch] : cb[ch]; }
    __syncthreads();
    u32x4 raw[3][3]; float dtr = 0.f;
#define SD_LOAD(J0) do { const int t_ = tid >> 3, c8_ = (tid & 7) * 8; const int row_ = scan_row(b, dir, (J0) + t_, false), rp_ = row_prev(row_), rn_ = row_next(row_); \
        _Pragma("unroll") for (int wh_ = 0; wh_ < 3; ++wh_) { const int col_ = (wh_ == 0 ? PC_SSD_X + head * 64 : wh_ == 1 ? PC_SSD_B + grp * 64 : PC_SSD_C + grp * 64) + c8_; \
            if (OUT && second) raw[wh_][1] = GLD(u32x4, xbc + (size_t)(SC - 1 - ((J0) - scidx * SC + t_)) * 192 + wh_ * 64 + c8_); \
            else if (OUT || wh_ != 2) { raw[wh_][0] = ldp8(P, rp_, col_); raw[wh_][1] = ldp8(P, row_, col_); raw[wh_][2] = ldp8(P, rn_, col_); } } \
        if (tid < 64) dtr = GLD(float, G32 + (size_t)scan_row(b, dir, (J0) + tid, false) * 32 + dir * 8 + head); } while (0)
    SD_LOAD(scidx * SC);
#pragma unroll 1
    for (int sub = 0; sub < SC / sd::T; ++sub) {
        const int j0 = scidx * SC + sub * sd::T;
        { const int t = tid >> 3, c8 = (tid & 7) * 8;
#pragma unroll
          for (int which = 0; which < (OUT ? 3 : 2); ++which) { __builtin_amdgcn_sched_barrier(0);
              const int cl = which * 64 + c8;
              u32x4 wv;
              if (OUT && second) wv = raw[which][1];
              else { float xm[8], x0[8], xp[8]; unpack8(raw[which][0], xm); unpack8(raw[which][1], x0); unpack8(raw[which][2], xp);
                  float o[8];
#pragma unroll
                  for (int j = 0; j < 8; ++j) o[j] = siluf_(cwl[cl + j] * xm[j] + cwl[192 + cl + j] * x0[j] + cwl[384 + cl + j] * xp[j] + cwl[576 + cl + j]);
                  wv.x = cvt_pk_bf16(o[0], o[1]); wv.y = cvt_pk_bf16(o[2], o[3]); wv.z = cvt_pk_bf16(o[4], o[5]); wv.w = cvt_pk_bf16(o[6], o[7]);
                  if (OUT) GST(u32x4, xbc + (size_t)(sub * sd::T + t) * 192 + which * 64 + c8) = wv; }
              const unsigned hw[4] = {wv.x, wv.y, wv.z, wv.w};
              if (which == 0) {
#pragma unroll
                  for (int j = 0; j < 8; ++j) xT[(c8 + j) * 72 + tphys<8, 3>(c8 + j, t)] = (bf16_t)((hw[j >> 1] >> ((j & 1) * 16)) & 0xFFFFu); }
              else { *(LAS u32x4*)((which == 1 ? Bm : Cm) + t * 72 + c8) = wv;
                  if (which == 1) {
#pragma unroll
                      for (int j = 0; j < 8; ++j) BT[(c8 + j) * 72 + tphys<8, 3>(c8 + j, t)] = (bf16_t)((hw[j >> 1] >> ((j & 1) * 16)) & 0xFFFFu); } } }
          if (tid < 64) { const float dt = softplusf_(dtr + dtb); sc[sd::DT + tid] = dt; sc[sd::DA + tid] = dt * Aneg; } }
        __syncthreads();
        if (sub + 1 < SC / sd::T) SD_LOAD(j0 + sd::T);
        u32x4 zraw = (u32x4){0u, 0u, 0u, 0u}; f32x4 pk0 = (f32x4){0.f, 0.f, 0.f, 0.f}, pk1 = pk0;
        if (OUT && second) { const int t = tid >> 3, c8 = (tid & 7) * 8; const int jl = sub * sd::T + t, tl = dir ? (SC - 1 - jl) : jl;
            const float* sp = oscr + (size_t)tl * 64 + c8; pk0 = GLD(f32x4, sp); pk1 = GLD(f32x4, sp + 4);
            zraw = GLD(u32x4, P + (size_t)scan_row(b, dir, j0 + t, false) * PCOLS + PC_SSD_Z + head * 64 + c8); }
        __syncthreads();
        { float x = sc[sd::DA + lane];
            x = wave_scan_incl(x);
            sc[sd::ACS + lane] = x; WAVE_LDS_SYNC(); }
        const float aend = sc[sd::ACS + 63];
        { const int s = tid >> 3, c8 = (tid & 7) * 8; const float ws = __expf(aend - sc[sd::ACS + s]) * sc[sd::DT + s];
#pragma unroll
          for (int j = 0; j < 8; ++j) { const int pi = (c8 + j) * 72 + tphys<8, 3>(c8 + j, s); wxT[pi] = f2bf1(bf2f(xT[pi]) * ws); } }
        if (OUT) {
#pragma unroll
            for (int q = 0; q < 2; ++q) { const int idx = w * 2 + q, tt = idx >> 2, ss = idx & 3;
                f32x4 a = (f32x4){0.f, 0.f, 0.f, 0.f};
                if (ss <= tt) a = mma_nt(Cm + tt * 16 * 72, 72, Bm + ss * 16 * 72, 72, 64, a, lane);
                const int s = ss * 16 + (lane & 15); const float as = sc[sd::ACS + s], ds = sc[sd::DT + s];
#pragma unroll
                for (int r = 0; r < 4; ++r) { const int t = tt * 16 + (lane >> 4) * 4 + r;
                    Scm[t * 72 + s] = f2bf1(s <= t ? a[r] * __expf(sc[sd::ACS + t] - as) * ds : 0.f); } } }
        __syncthreads();
        if (OUT) {
#pragma unroll
            for (int q = 0; q < 2; ++q) { const int idx = w * 2 + q, tt = idx >> 2, pt = idx & 3;
                f32x4 a1 = mma_nt(Scm + tt * 16 * 72, 72, xT + pt * 16 * 72, 72, 64, (f32x4){0.f, 0.f, 0.f, 0.f}, lane, -1, (pt * 16 + (lane & 15)) >> 3);
                f32x4 a2 = mma_nt(Cm + tt * 16 * 72, 72, Hb + pt * 16 * 72, 72, 64, (f32x4){0.f, 0.f, 0.f, 0.f}, lane);
#pragma unroll
                for (int r = 0; r < 4; ++r) { const int t = tt * 16 + (lane >> 4) * 4 + r; ob[t * 68 + pt * 16 + (lane & 15)] = a1[r] + __expf(sc[sd::ACS + t]) * a2[r]; } } }
        __syncthreads();
        { const float ea = __expf(aend);
#pragma unroll
          for (int q = 0; q < 2; ++q) { const int idx = w * 2 + q, pt = idx >> 2, nt = idx & 3;
              f32x4 a = hacc[q] * ea; a = mma_nt(wxT + pt * 16 * 72, 72, BT + nt * 16 * 72, 72, 64, a, lane, (pt * 16 + (lane & 15)) >> 3, (nt * 16 + (lane & 15)) >> 3); hacc[q] = a;
              if (OUT) {
#pragma unroll
                  for (int r = 0; r < 4; ++r) Hb[(pt * 16 + (lane >> 4) * 4 + r) * 72 + nt * 16 + (lane & 15)] = f2bf1(a[r]); } } }
        dec_log += aend;
        if (OUT) { const int t = tid >> 3, c8 = (tid & 7) * 8; const int jl = sub * sd::T + t, tl = dir ? (SC - 1 - jl) : jl;
            float o[8];
#pragma unroll
            for (int j = 0; j < 8; ++j) o[j] = ob[t * 68 + c8 + j];
            float* sp = oscr + (size_t)tl * 64 + c8;
            if (!second) { GST(f32x4, sp) = (f32x4){o[0], o[1], o[2], o[3]}; GST(f32x4, sp + 4) = (f32x4){o[4], o[5], o[6], o[7]}; }
            else { const f32x4 p0 = pk0, p1 = pk1;
                o[0] += p0[0]; o[1] += p0[1]; o[2] += p0[2]; o[3] += p0[3]; o[4] += p1[0]; o[5] += p1[1]; o[6] += p1[2]; o[7] += p1[3];
                const int row = scan_row(b, dir, j0 + t, false); const float dsk = inp(F, I_SSD_D)[l * 8 + head];
                float z[8]; unpack8(zraw, z);
                const float* ng = inp(F, I_SSD_NG) + (size_t)l * 512 + head * 64 + c8;
                float ss = 0.f, y[8];
#pragma unroll
                for (int j = 0; j < 8; ++j) { const float g = (o[j] + dsk * bf2f(xT[(c8 + j) * 72 + tphys<8, 3>(c8 + j, t)])) * siluf_(z[j]); ss += g * g; y[j] = g * ng[j]; }
                ss += __shfl_xor(ss, 1); ss += __shfl_xor(ss, 2); ss += __shfl_xor(ss, 4);
                if ((tid & 7) == 0) GST(float, WSP(float, wsmap::SSQ) + (size_t)row * 8 + head) = ss;
                u32x4 wv; wv.x = cvt_pk_bf16(y[0], y[1]); wv.y = cvt_pk_bf16(y[2], y[3]); wv.z = cvt_pk_bf16(y[4], y[5]); wv.w = cvt_pk_bf16(y[6], y[7]);
                GST(u32x4, WSP(bf16_t, wsmap::HYB) + (size_t)row * HY_LD + 1024 + head * 64 + c8) = wv; } }
        __syncthreads();
    }
}
__device__ __forceinline__ void sd_m1_item(const Frame& F, int l, int it) {
    const int chain = it / NSC, sc = it % NSC, head = chain & 7, dir = (chain >> 3) & 1, b = chain >> 4;
    f32x4 hacc[2] = {(f32x4){0.f, 0.f, 0.f, 0.f}, (f32x4){0.f, 0.f, 0.f, 0.f}};
    float dl = 0.f;
    __syncthreads();
    sd_pass<false>(F, l, b, dir, head, sc, hacc, dl, false);
    { LAS float* stg = (LAS float*)(F.lds + sd::OB);
#pragma unroll
      for (int q = 0; q < 2; ++q) { const int idx = F.wave * 2 + q, pt = idx >> 2, nt = idx & 3;
#pragma unroll
          for (int r = 0; r < 4; ++r) stg[(pt * 16 + (F.lane >> 4) * 4 + r) * 64 + nt * 16 + (F.lane & 15)] = hacc[q][r]; }
      __syncthreads();
      copy_l2g(F, stg, WSP(bf16_t, wsmap::ST_SSD) + (size_t)it * 4096, 4096); }
    if (F.tid == 0) WSP(float, wsmap::DEC_SSD)[it] = __expf(dl);
}
__device__ __forceinline__ void sd_m3_item(const Frame& F, int l, int it) {
    const int c = it % NSC, bh = it / NSC, head = bh & 7, b = bh >> 3;
    f32x4 hacc[2];
#pragma unroll
    for (int dir = 0; dir < 2; ++dir) { const int scidx = dir ? sc_mirror(c) : c; const int chain = (b * 2 + dir) * 8 + head;
        LAS bf16_t* Hb = (LAS bf16_t*)(F.lds + sd::HB); LAS float* stg = (LAS float*)(F.lds + sd::OB);
        __syncthreads();
        copy_g2l(F, WSP(bf16_t, wsmap::ST_SSD) + ((size_t)chain * NSC + scidx) * 4096, stg, 4096);
        __syncthreads();
#pragma unroll
        for (int q = 0; q < 2; ++q) { const int idx = F.wave * 2 + q, pt = idx >> 2, nt = idx & 3;
#pragma unroll
            for (int r = 0; r < 4; ++r) { const int p = pt * 16 + (F.lane >> 4) * 4 + r, n = nt * 16 + (F.lane & 15); const float x = stg[p * 64 + n]; hacc[q][r] = x; Hb[p * 72 + n] = f2bf1(x); } }
        __syncthreads();
        float dl = 0.f;
        sd_pass<true>(F, l, b, dir, head, scidx, hacc, dl, dir == 1); }
}
__device__ __forceinline__ void ml_m1f_item(const Frame& F, int l, int it) {
    const int c = it % NSC, bh = it / NSC, head = bh & 3, b = bh >> 2;
    LAS unsigned char* L = F.lds; const int tid = F.tid, lane = F.lane, w = F.wave;
    LAS bf16_t* kb = (LAS bf16_t*)(L + ml::KB); LAS bf16_t* vT = (LAS bf16_t*)(L + ml::VT); LAS bf16_t* wkF = (LAS bf16_t*)(L + ml::WKT); LAS bf16_t* wkB = (LAS bf16_t*)(L + ml::CB);
    LAS float* sc = (LAS float*)(L + ml::SCAL); LAS float* cwl = (LAS float*)(L + ml::CWL);
    constexpr int BCF = 0, LIF = 64, EXB = 128, LFF = 192, LIB = 256, LFB = 320;
    const bf16_t* P = WSP(bf16_t, wsmap::P); const float* G32 = WSP(float, wsmap::G32);
    const float* cw = inp(F, I_ML_CW) + (size_t)l * 3 * 1024; const float* cb = inp(F, I_ML_CB) + (size_t)l * 1024;
    const float ibf = inp(F, I_ML_IB)[(l * 2 + 0) * 4 + head], ibb = inp(F, I_ML_IB)[(l * 2 + 1) * 4 + head];
    const float fbf = inp(F, I_ML_FB)[(l * 2 + 0) * 4 + head], fbb = inp(F, I_ML_FB)[(l * 2 + 1) * 4 + head];
    f32x4 cf[9], cbw[9];
#pragma unroll
    for (int vt = 0; vt < 9; ++vt) { cf[vt] = (f32x4){0.f, 0.f, 0.f, 0.f}; cbw[vt] = cf[vt]; }
    __syncthreads();
    ml_vt_ones(F);
    if (tid < 256) { const int qc = 128 + (tid & 127), j = tid >> 7, ch = 512 + head * 128 + (tid & 127);
        cwl[j * 256 + qc] = cw[j * 1024 + ch]; cwl[(j + 2) * 256 + qc] = j ? cb[ch] : cw[2048 + ch]; }
    __syncthreads();
    u32x4 rk[2], rkh[2], rv[2]; float g4[4] = {0.f, 0.f, 0.f, 0.f};
#define MLF_LOAD(J0) do { const int t_ = tid >> 3, c16_ = (tid & 7) * 16; const int row_ = scan_row(b, 0, (J0) + t_, false); \
        const int hrow_ = lane < 8 ? row_prev(row_) : (lane >= 56 ? row_next(row_) : -1); \
        _Pragma("unroll") for (int hh_ = 0; hh_ < 2; ++hh_) { rk[hh_] = ldp8(P, row_, PC_ML_K + head * 128 + c16_ + hh_ * 8); rkh[hh_] = ldp8(P, hrow_, PC_ML_K + head * 128 + c16_ + hh_ * 8); rv[hh_] = GLD(u32x4, P + (size_t)row_ * PCOLS + PC_ML_V + head * 128 + c16_ + hh_ * 8); } \
        if (tid < 64) { const float* gp_ = G32 + (size_t)scan_row(b, 0, (J0) + tid, false) * 32 + 16 + head; g4[0] = GLD(float, gp_); g4[1] = GLD(float, gp_ + 4); g4[2] = GLD(float, gp_ + 8); g4[3] = GLD(float, gp_ + 12); } } while (0)
    MLF_LOAD(c * SC);
    float offb = 0.f, declf = 0.f;
#pragma unroll 1
    for (int sub = 0; sub < SC / ml::T; ++sub) {
        const int j0 = c * SC + sub * ml::T;
        { const int t = tid >> 3, c16 = (tid & 7) * 16;
#pragma unroll
          for (int hh = 0; hh < 2; ++hh) { __builtin_amdgcn_sched_barrier(0); const int c8 = c16 + hh * 8;
              const u32x4 cur = rk[hh], hal = rkh[hh]; u32x4 lo, hi;
              lo.x = __shfl_up(cur.x, 8); lo.y = __shfl_up(cur.y, 8); lo.z = __shfl_up(cur.z, 8); lo.w = __shfl_up(cur.w, 8);
              hi.x = __shfl_down(cur.x, 8); hi.y = __shfl_down(cur.y, 8); hi.z = __shfl_down(cur.z, 8); hi.w = __shfl_down(cur.w, 8);
              if (lane < 8) lo = hal; if (lane >= 56) hi = hal;
              float xm[8], x0[8], xp[8]; unpack8(lo, xm); unpack8(cur, x0); unpack8(hi, xp);
              float o[8];
#pragma unroll
              for (int j = 0; j < 8; ++j) { const int cl = 128 + c8 + j; o[j] = siluf_(cwl[cl] * xm[j] + cwl[256 + cl] * x0[j] + cwl[512 + cl] * xp[j] + cwl[768 + cl]) * 0.08838834764831845f; }
              u32x4 wv; wv.x = cvt_pk_bf16(o[0], o[1]); wv.y = cvt_pk_bf16(o[2], o[3]); wv.z = cvt_pk_bf16(o[4], o[5]); wv.w = cvt_pk_bf16(o[6], o[7]);
              *(LAS u32x4*)(kb + t * 136 + c8) = wv;
              const unsigned vw[4] = {rv[hh].x, rv[hh].y, rv[hh].z, rv[hh].w};
#pragma unroll
              for (int j = 0; j < 8; ++j) vT[(c8 + j) * 72 + tphys<8, 4>(c8 + j, t)] = (bf16_t)((vw[j >> 1] >> ((j & 1) * 16)) & 0xFFFFu); }
          if (tid < 64) { sc[LIF + tid] = g4[0] + ibf; sc[LIB + tid] = g4[1] + ibb; sc[LFF + tid] = logsigmoidf_(g4[2] + fbf); sc[LFB + tid] = logsigmoidf_(g4[3] + fbb); } }
        __syncthreads();
        if (sub + 1 < SC / ml::T) MLF_LOAD(j0 + ml::T);
        float btot, totb;
        { float xf = sc[LFF + lane], xb = sc[LFB + lane]; const float ownb = xb;
          xf = wave_scan_incl(xf); xb = wave_scan_incl(xb);
          sc[BCF + lane] = xf; sc[EXB + lane] = xb - ownb; WAVE_LDS_SYNC();
          btot = sc[BCF + 63]; totb = sc[EXB + 63] + sc[LFB + 63]; }
        { const int s = tid >> 3, c16 = (tid & 7) * 16; const float wf = __expf(btot - sc[BCF + s] + sc[LIF + s]), wb = __expf(offb + sc[EXB + s] + sc[LIB + s]);
#pragma unroll
          for (int j = 0; j < 16; ++j) { const float kv = bf2f(kb[s * 136 + c16 + j]); const int pi = (c16 + j) * 72 + tphys<8, 4>(c16 + j, s); wkF[pi] = f2bf1(kv * wf); wkB[pi] = f2bf1(kv * wb); } }
        __syncthreads();
        { const float eb = __expf(btot);
#pragma unroll
          for (int vt = 0; vt < 9; ++vt) { if (vt % 3 == 0) __builtin_amdgcn_sched_barrier(0);
              f32x4 a = cf[vt] * eb; a = mma_nt(vT + vt * 16 * 72, 72, wkF + w * 16 * 72, 72, 64, a, lane, vt, w); cf[vt] = a;
              cbw[vt] = mma_nt(vT + vt * 16 * 72, 72, wkB + w * 16 * 72, 72, 64, cbw[vt], lane, vt, w); } }
        declf += btot; offb += totb;
        __syncthreads();
    }
#undef MLF_LOAD
#pragma unroll
    for (int dir = 0; dir < 2; ++dir) { const int chain = (b * 2 + dir) * 4 + head, scidx = dir ? sc_mirror(c) : c;
        LAS float* stg = (LAS float*)F.lds; LAS float* sp = stg + ((lane >> 4) * 4) * 128 + w * 16 + (lane & 15);
        __syncthreads();
#pragma unroll
        for (int vt = 0; vt < 9; ++vt)
#pragma unroll
            for (int r = 0; r < 4; ++r) sp[(vt * 16 + r) * 128] = dir ? cbw[vt][r] : cf[vt][r];
        __syncthreads();
        copy_l2g(F, stg, WSP(bf16_t, wsmap::ST_ML) + ((size_t)chain * NSC + scidx) * 144 * 128, 144 * 128);
        if (tid == 0) WSP(float, wsmap::DEC_ML)[(size_t)chain * NSC + scidx] = __expf(dir ? offb : declf); }
}
__device__ __forceinline__ void sd_m1f_item(const Frame& F, int l, int it) {
    const int c = it % NSC, bh = it / NSC, head = bh & 7, b = bh >> 3, grp = head >> 2;
    LAS unsigned char* L = F.lds; const int tid = F.tid, lane = F.lane, w = F.wave;
    LAS bf16_t* xT = (LAS bf16_t*)(L + sd::XT); LAS bf16_t* wxF = (LAS bf16_t*)(L + sd::WXT); LAS bf16_t* wxB = (LAS bf16_t*)(L + sd::SCM); LAS bf16_t* BT = (LAS bf16_t*)(L + sd::BTR);
    LAS float* sc = (LAS float*)(L + sd::SCAL); LAS float* cwl = (LAS float*)(L + sd::CWL);
    constexpr int ACF = 0, DTF = 64, DAF = 128, EXB = 192, DTB = 256, DAB = 320;
    const bf16_t* P = WSP(bf16_t, wsmap::P); const float* G32 = WSP(float, wsmap::G32);
    const float* cw = inp(F, I_SSD_CW) + (size_t)l * 3 * 768; const float* cb = inp(F, I_SSD_CB) + (size_t)l * 768;
    const float dtbf = inp(F, I_SSD_DTB)[(l * 2 + 0) * 8 + head], dtbb = inp(F, I_SSD_DTB)[(l * 2 + 1) * 8 + head];
    const float Af = -__expf(inp(F, I_SSD_ALOG)[(l * 2 + 0) * 8 + head]), Ab = -__expf(inp(F, I_SSD_ALOG)[(l * 2 + 1) * 8 + head]);
    f32x4 hf[2], hb[2];
#pragma unroll
    for (int q = 0; q < 2; ++q) { hf[q] = (f32x4){0.f, 0.f, 0.f, 0.f}; hb[q] = hf[q]; }
    __syncthreads();
    for (int i = tid; i < 768; i += NTHREADS) { const int j = i / 192, qc = i % 192, ch = (qc < 64 ? head * 64 + qc : qc < 128 ? 512 + grp * 64 + (qc - 64) : 640 + grp * 64 + (qc - 128));
        cwl[i] = j < 3 ? cw[j * 768 + ch] : cb[ch]; }
    __syncthreads();
    u32x4 raw[2][3]; float d2[2] = {0.f, 0.f};
#define SDF_LOAD(J0) do { const int t_ = tid >> 3, c8_ = (tid & 7) * 8; const int row_ = scan_row(b, 0, (J0) + t_, false), rp_ = row_prev(row_), rn_ = row_next(row_); \
        _Pragma("unroll") for (int wh_ = 0; wh_ < 2; ++wh_) { const int col_ = (wh_ == 0 ? PC_SSD_X + head * 64 : PC_SSD_B + grp * 64) + c8_; \
            raw[wh_][0] = ldp8(P, rp_, col_); raw[wh_][1] = ldp8(P, row_, col_); raw[wh_][2] = ldp8(P, rn_, col_); } \
        if (tid < 64) { const float* gp_ = G32 + (size_t)scan_row(b, 0, (J0) + tid, false) * 32 + head; d2[0] = GLD(float, gp_); d2[1] = GLD(float, gp_ + 8); } } while (0)
    SDF_LOAD(c * SC);
    float offb = 0.f, declf = 0.f;
#pragma unroll 1
    for (int sub = 0; sub < SC / sd::T; ++sub) {
        const int j0 = c * SC + sub * sd::T;
        { const int t = tid >> 3, c8 = (tid & 7) * 8;
#pragma unroll
          for (int which = 0; which < 2; ++which) { __builtin_amdgcn_sched_barrier(0);
              const int cl = which * 64 + c8;
              float xm[8], x0[8], xp[8]; unpack8(raw[which][0], xm); unpack8(raw[which][1], x0); unpack8(raw[which][2], xp);
#pragma unroll
              for (int j = 0; j < 8; ++j) { const float o = siluf_(cwl[cl + j] * xm[j] + cwl[192 + cl + j] * x0[j] + cwl[384 + cl + j] * xp[j] + cwl[576 + cl + j]);
                  (which ? BT : xT)[(c8 + j) * 72 + tphys<8, 3>(c8 + j, t)] = f2bf1(o); } }
          if (tid < 64) { const float dtf = softplusf_(d2[0] + dtbf), dtb2 = softplusf_(d2[1] + dtbb);
              sc[DTF + tid] = dtf; sc[DAF + tid] = dtf * Af; sc[DTB + tid] = dtb2; sc[DAB + tid] = dtb2 * Ab; } }
        __syncthreads();
        if (sub + 1 < SC / sd::T) SDF_LOAD(j0 + sd::T);
        float aend, totb;
        { float xf = sc[DAF + lane], xb = sc[DAB + lane]; const float ownb = xb;
          xf = wave_scan_incl(xf); xb = wave_scan_incl(xb);
          sc[ACF + lane] = xf; sc[EXB + lane] = xb - ownb; WAVE_LDS_SYNC();
          aend = sc[ACF + 63]; totb = sc[EXB + 63] + sc[DAB + 63]; }
        { const int s = tid >> 3, c8 = (tid & 7) * 8; const float wf = __expf(aend - sc[ACF + s]) * sc[DTF + s], wb = __expf(offb + sc[EXB + s]) * sc[DTB + s];
#pragma unroll
          for (int j = 0; j < 8; ++j) { const int pi = (c8 + j) * 72 + tphys<8, 3>(c8 + j, s); const float xv = bf2f(xT[pi]); wxF[pi] = f2bf1(xv * wf); wxB[pi] = f2bf1(xv * wb); } }
        __syncthreads();
        { const float ea = __expf(aend);
#pragma unroll
          for (int q = 0; q < 2; ++q) { const int idx = w * 2 + q, pt = idx >> 2, nt = idx & 3; const int ra = (pt * 16 + (lane & 15)) >> 3, rb = (nt * 16 + (lane & 15)) >> 3;
              f32x4 a = hf[q] * ea; a = mma_nt(wxF + pt * 16 * 72, 72, BT + nt * 16 * 72, 72, 64, a, lane, ra, rb); hf[q] = a;
              hb[q] = mma_nt(wxB + pt * 16 * 72, 72, BT + nt * 16 * 72, 72, 64, hb[q], lane, ra, rb); } }
        declf += aend; offb += totb;
        __syncthreads();
    }
#undef SDF_LOAD
#pragma unroll
    for (int dir = 0; dir < 2; ++dir) { const int chain = (b * 2 + dir) * 8 + head, scidx = dir ? sc_mirror(c) : c;
        LAS float* stg = (LAS float*)(F.lds + sd::OB);
        __syncthreads();
#pragma unroll
        for (int q = 0; q < 2; ++q) { const int idx = w * 2 + q, pt = idx >> 2, nt = idx & 3;
#pragma unroll
            for (int r = 0; r < 4; ++r) stg[(pt * 16 + (lane >> 4) * 4 + r) * 64 + nt * 16 + (lane & 15)] = dir ? hb[q][r] : hf[q][r]; }
        __syncthreads();
        copy_l2g(F, stg, WSP(bf16_t, wsmap::ST_SSD) + ((size_t)chain * NSC + scidx) * 4096, 4096);
        if (tid == 0) WSP(float, wsmap::DEC_SSD)[(size_t)chain * NSC + scidx] = __expf(dir ? offb : declf); }
}
namespace hgf { constexpr int T = 32, KFF = 0, KFB = 16896, BFF = 33792, BFB = 50688, VT = 67584, KTF = 77824, KTB = 88064, BTOT = 98304, OFFB = 98816, TOTB = 99328, SEG = 99840, END = 103936; }
__device__ __forceinline__ void hg_m1f_item(const Frame& F, int l, int it) {
    const int c = it % NSC, bh = it / NSC, head = bh & 3, b = bh >> 2;
    LAS unsigned char* L = F.lds; const int tid = F.tid, lane = F.lane, w = F.wave;
    LAS float* kff = (LAS float*)(L + hgf::KFF); LAS float* kfb = (LAS float*)(L + hgf::KFB); LAS float* bff = (LAS float*)(L + hgf::BFF); LAS float* bfb = (LAS float*)(L + hgf::BFB);
    LAS bf16_t* vT = (LAS bf16_t*)(L + hgf::VT); LAS bf16_t* kTf = (LAS bf16_t*)(L + hgf::KTF); LAS bf16_t* kTb = (LAS bf16_t*)(L + hgf::KTB);
    LAS float* btot = (LAS float*)(L + hgf::BTOT); LAS float* offb = (LAS float*)(L + hgf::OFFB); LAS float* totb = (LAS float*)(L + hgf::TOTB); LAS float* seg = (LAS float*)(L + hgf::SEG);
    const bf16_t* P = WSP(bf16_t, wsmap::P); const float* lbp = WSP(float, wsmap::LB) + l * 512 + head * 128;
    f32x4 sf[8], sb[8];
#pragma unroll
    for (int kt = 0; kt < 8; ++kt) { sf[kt] = (f32x4){0.f, 0.f, 0.f, 0.f}; sb[kt] = sf[kt]; }
    __syncthreads();
    if (tid < 128) { offb[tid] = 0.f; btot[tid] = 0.f; }
    LAS float* fsum = (LAS float*)(L + hgf::SEG + 2048 + 1024);
    if (tid < 128) fsum[tid] = 0.f;
    __syncthreads();
    float lbv[8];
#pragma unroll
    for (int j = 0; j < 8; ++j) lbv[j] = GLD(float, lbp + (tid & 15) * 8 + j);
    u32x4 rff, rfb, rv;
    { const bf16_t* pr = P + (size_t)scan_row(b, 0, c * SC + (tid >> 4), true) * PCOLS + head * 128 + (tid & 15) * 8;
      rff = GLD(u32x4, pr + PC_HG_FF); rfb = GLD(u32x4, pr + PC_HG_FB); rv = GLD(u32x4, pr + PC_HG_I); }
#pragma unroll 1
    for (int sub = 0; sub < SC / hgf::T; ++sub) {
        const int j0 = c * SC + sub * hgf::T;
        { const int t = tid >> 4, c8 = (tid & 15) * 8;
          float ff[8], fb[8];
          unpack8(rff, ff); unpack8(rfb, fb);
          const u32x4 vraw = rv;
          if (sub + 1 < SC / hgf::T) { const bf16_t* pr = P + (size_t)scan_row(b, 0, j0 + hgf::T + t, true) * PCOLS + head * 128 + c8;
              rff = GLD(u32x4, pr + PC_HG_FF); rfb = GLD(u32x4, pr + PC_HG_FB); rv = GLD(u32x4, pr + PC_HG_I); }
#pragma unroll
          for (int j = 0; j < 8; ++j) { const float lb = lbv[j], sgf = sigmoidf_(ff[j]), sgb = sigmoidf_(fb[j]); const float lbc = fmaxf(lb, 1e-30f), ub = 1.0f - lb;
              kff[t * 132 + c8 + j] = ub * (1.0f - sgf); kfb[t * 132 + c8 + j] = ub * (1.0f - sgb);
              bff[t * 132 + c8 + j] = __logf(lbc + ub * sgf); bfb[t * 132 + c8 + j] = __logf(lbc + ub * sgb); }
          const unsigned vw[4] = {vraw.x, vraw.y, vraw.z, vraw.w};
#pragma unroll
          for (int j = 0; j < 8; ++j) vT[(c8 + j) * 40 + tphys<4, 3>(c8 + j, t)] = (bf16_t)((vw[j >> 1] >> ((j & 1) * 16)) & 0xFFFFu); }
        __syncthreads();
        { const int k = tid & 127, sg = tid >> 7;
          float vf[8], vb[8]; float rf = 0.f, rb = 0.f;
#pragma unroll
          for (int i = 0; i < 8; ++i) { rf += bff[(sg * 8 + i) * 132 + k]; vf[i] = rf; vb[i] = rb; rb += bfb[(sg * 8 + i) * 132 + k]; }
          seg[sg * 128 + k] = rf; seg[512 + sg * 128 + k] = rb;
          __syncthreads();
          float of = 0.f, ob2 = 0.f;
#pragma unroll
          for (int s2 = 0; s2 < 3; ++s2) { of += (s2 < sg) ? seg[s2 * 128 + k] : 0.f; ob2 += (s2 < sg) ? seg[512 + s2 * 128 + k] : 0.f; }
#pragma unroll
          for (int i = 0; i < 8; ++i) { bff[(sg * 8 + i) * 132 + k] = vf[i] + of; bfb[(sg * 8 + i) * 132 + k] = vb[i] + ob2; }
          if (sg == 3) { btot[k] = rf + of; totb[k] = rb + ob2; } }
        __syncthreads();
        { const int t = tid >> 4, c8 = (tid & 15) * 8;
#pragma unroll
          for (int j = 0; j < 8; ++j) { const int k = c8 + j; const int pi = k * 40 + tphys<4, 3>(k, t);
              kTf[pi] = f2bf1(kff[t * 132 + k] * __expf(btot[k] - bff[t * 132 + k]));
              kTb[pi] = f2bf1(kfb[t * 132 + k] * __expf(fminf(offb[k] + bfb[t * 132 + k], 0.f))); } }
        __syncthreads();
#pragma unroll
        for (int kt = 0; kt < 8; ++kt) { if ((kt & 3) == 0) __builtin_amdgcn_sched_barrier(0); const float e = __expf(btot[kt * 16 + (lane & 15)]);
            const int ra = (w * 16 + (lane & 15)) >> 3, rb2 = (kt * 16 + (lane & 15)) >> 3;
            f32x4 a = sf[kt] * e; a = mma_nt(vT + w * 16 * 40, 40, kTf + kt * 16 * 40, 40, 32, a, lane, ra, rb2); sf[kt] = a;
            sb[kt] = mma_nt(vT + w * 16 * 40, 40, kTb + kt * 16 * 40, 40, 32, sb[kt], lane, ra, rb2); }
        if (tid < 128) { offb[tid] += totb[tid]; fsum[tid] += btot[tid]; }
        __syncthreads();
    }
#pragma unroll
    for (int dir = 0; dir < 2; ++dir) { const int chain = (b * 2 + dir) * 4 + head, scidx = dir ? sc_mirror(c) : c;
        LAS float* stg = (LAS float*)F.lds; LAS float* sp = stg + (w * 16 + (lane >> 4) * 4) * 128 + (lane & 15);
        float dk = 0.f; if (tid < 128) dk = __expf(dir ? offb[tid] : fsum[tid]);
        __syncthreads();
#pragma unroll
        for (int kt = 0; kt < 8; ++kt)
#pragma unroll
            for (int r = 0; r < 4; ++r) sp[r * 128 + kt * 16] = dir ? sb[kt][r] : sf[kt][r];
        __syncthreads();
        copy_l2g(F, stg, WSP(bf16_t, wsmap::ST_HG) + ((size_t)chain * NSC + scidx) * 16384, 16384);
        if (tid < 128) WSP(float, wsmap::DEC_HG)[((size_t)chain * NSC + scidx) * 128 + tid] = dk; }
}
constexpr int M2_SSD = 32 * 4096 / (2 * NTHREADS), M2_ML = 16 * 144 * 128 / (2 * NTHREADS), M2_HG = 16 * 16384 / (2 * NTHREADS);
template <int DECMODE> __device__ __forceinline__ void carry_run(unsigned* p0, size_t pw, const float* dec0) {
    constexpr int CB = 13;
    float run0 = 0.f, run1 = 0.f;
#pragma unroll 1
    for (int cb = 0; cb < NSC; cb += CB) {
        unsigned loc[CB]; float d0[CB], d1[CB];
#pragma unroll
        for (int i = 0; i < CB; ++i) { const int c = cb + i < NSC ? cb + i : NSC - 1; loc[i] = GLD(unsigned, p0 + (size_t)c * pw);
            if (DECMODE) { const f32x2 dd = GLD(f32x2, dec0 + (size_t)c * 128); d0[i] = dd.x; d1[i] = dd.y; } else { d0[i] = d1[i] = GLD(float, dec0 + c); } }
        __builtin_amdgcn_sched_barrier(0);
#pragma unroll
        for (int i = 0; i < CB; ++i) if (cb + i < NSC) { GST(unsigned, p0 + (size_t)(cb + i) * pw) = cvt_pk_bf16(run0, run1); run0 = d0[i] * run0 + bflo(loc[i]); run1 = d1[i] * run1 + bfhi(loc[i]); }
    }
}
__device__ __forceinline__ void carry_item(const Frame& F, int it) {
    bf16_t* st; const float* dec; size_t per; int chain, e; int decmode;
    if (it < M2_SSD) { const int g = (it * NTHREADS + F.tid) * 2; chain = g / 4096; e = g % 4096; st = WSP(bf16_t, wsmap::ST_SSD); dec = WSP(float, wsmap::DEC_SSD); per = 4096; decmode = 0; }
    else if (it < M2_SSD + M2_ML) { const int g = ((it - M2_SSD) * NTHREADS + F.tid) * 2; chain = g / (144 * 128); e = g % (144 * 128); st = WSP(bf16_t, wsmap::ST_ML); dec = WSP(float, wsmap::DEC_ML); per = 144 * 128; decmode = 0; }
    else { const int g = ((it - M2_SSD - M2_ML) * NTHREADS + F.tid) * 2; chain = g / 16384; e = g % 16384; st = WSP(bf16_t, wsmap::ST_HG); dec = WSP(float, wsmap::DEC_HG); per = 16384; decmode = 1; }
    unsigned* p0 = (unsigned*)(st + (size_t)chain * NSC * per + e); const size_t pw = per / 2;
    if (decmode) carry_run<1>(p0, pw, dec + (size_t)chain * NSC * 128 + (e & 127)); else carry_run<0>(p0, pw, dec + (size_t)chain * NSC);
}
__device__ __forceinline__ f32x2 cmul(f32x2 a, f32x2 b) { return a * (f32x2){b.x, b.x} + (f32x2){-a.y, a.x} * (f32x2){b.y, b.y}; }
__device__ __forceinline__ f32x2 cconj(f32x2 a) { return (f32x2){a.x, -a.y}; }
__device__ __forceinline__ f32x2 twid(float f) { return (f32x2){__builtin_amdgcn_cosf(f), -__builtin_amdgcn_sinf(f)}; }
__device__ __forceinline__ f32x2 mul_mi(f32x2 a) { return (f32x2){a.y, -a.x}; }
__device__ __forceinline__ f32x2 mul_pi(f32x2 a) { return (f32x2){-a.y, a.x}; }
__device__ __forceinline__ void dif8(f32x2 (&x)[8], f32x2 w1) {
    const float c = 0.70710678118654752f;
    const f32x2 w2 = cmul(w1, w1), w4 = cmul(w2, w2);
    const f32x2 t1 = (f32x2){c * (w1.x + w1.y), c * (w1.y - w1.x)};
    f32x2 u[4], v[4];
#pragma unroll
    for (int m = 0; m < 4; ++m) { u[m] = x[m] + x[m + 4]; v[m] = x[m] - x[m + 4]; }
    v[0] = cmul(v[0], w1); v[1] = cmul(v[1], t1); v[2] = cmul(mul_mi(v[2]), w1); v[3] = cmul(mul_mi(v[3]), t1);
#pragma unroll
    for (int hf = 0; hf < 2; ++hf) { f32x2* z = hf ? v : u;
        const f32x2 a0 = z[0] + z[2], a1 = z[1] + z[3], b0 = cmul(z[0] - z[2], w2), b1 = cmul(mul_mi(z[1] - z[3]), w2);
        x[hf * 4 + 0] = a0 + a1; x[hf * 4 + 1] = cmul(a0 - a1, w4); x[hf * 4 + 2] = b0 + b1; x[hf * 4 + 3] = cmul(b0 - b1, w4); }
}
__device__ __forceinline__ void dit8(f32x2 (&x)[8], f32x2 w1) {
    const float c = 0.70710678118654752f;
    const f32x2 cw1 = cconj(w1), cw2 = cmul(cw1, cw1), cw4 = cmul(cw2, cw2);
    const f32x2 ct1 = (f32x2){c * (cw1.x - cw1.y), c * (cw1.y + cw1.x)};
    f32x2 u[4], v[4];
#pragma unroll
    for (int hf = 0; hf < 2; ++hf) { f32x2* z = hf ? v : u;
        const f32x2 y1 = cmul(x[hf * 4 + 1], cw4), y3 = cmul(x[hf * 4 + 3], cw4);
        const f32x2 a0 = x[hf * 4 + 0] + y1, a1 = x[hf * 4 + 0] - y1, b0 = x[hf * 4 + 2] + y3, b1 = x[hf * 4 + 2] - y3;
        const f32x2 q0 = cmul(b0, cw2), q1 = mul_pi(cmul(b1, cw2));
        z[0] = a0 + q0; z[2] = a0 - q0; z[1] = a1 + q1; z[3] = a1 - q1; }
    v[0] = cmul(v[0], cw1); v[1] = cmul(v[1], ct1); v[2] = mul_pi(cmul(v[2], cw1)); v[3] = mul_pi(cmul(v[3], ct1));
#pragma unroll
    for (int m = 0; m < 4; ++m) { x[m] = u[m] + v[m]; x[m + 4] = u[m] - v[m]; }
}
__device__ __forceinline__ int zsw(int i) { return i ^ (((i >> 5) & 7) << 2); }
template <int E> __device__ __forceinline__ void fft_addr8(int j, int (&a)[8]) {
    const int p = j & (E - 1), base = ((j - p) << 3) + p;
    if constexpr (E >= 256) { const int b = zsw(base) << 3;
#pragma unroll
        for (int m = 0; m < 8; ++m) a[m] = b + m * E * 8; }
    else if constexpr (E == 32) { const int hi = (base & ~31) << 3;
#pragma unroll
        for (int m = 0; m < 8; ++m) a[m] = hi + m * 256 + ((p ^ (m << 2)) << 3); }
    else if constexpr (E == 4) { const int s = (base >> 5) & 7;
#pragma unroll
        for (int m = 0; m < 8; ++m) a[m] = (base + ((m ^ s) << 2)) << 3; }
    else {
#pragma unroll
        for (int m = 0; m < 8; ++m) a[m] = zsw(base + m * E) << 3; }
}
template <int N, int E, bool INV> __device__ __forceinline__ void fft_pass8(LAS f32x2* Z, int tid) {
    const float inv = 1.0f / (float)(8 * E);
    int t0 = tid;
#ifndef CPU_EMU
    asm volatile("" : "+v"(t0));
#endif
#pragma unroll 2
    for (int j = t0; j < N / 8; j += NTHREADS) { int a[8]; fft_addr8<E>(j, a);
        f32x2 x[8];
#pragma unroll
        for (int m = 0; m < 8; ++m) x[m] = *(const LAS f32x2*)((const LAS unsigned char*)Z + a[m]);
        if constexpr (INV) dit8(x, twid((float)(j & (E - 1)) * inv)); else dif8(x, twid((float)(j & (E - 1)) * inv));
#pragma unroll
        for (int m = 0; m < 8; ++m) *(LAS f32x2*)((LAS unsigned char*)Z + a[m]) = x[m]; }
    __syncthreads();
}
template <int N, int H> __device__ __forceinline__ void fft_dif_rec(LAS f32x2* Z, int tid) {
    if constexpr (H >= 4) { fft_pass8<N, H / 4, false>(Z, tid); fft_dif_rec<N, H / 8>(Z, tid); }
    else if constexpr (H == 2) {
        for (int j = tid; j < N / 4; j += NTHREADS) { const int ia = zsw(j << 2);
            const f32x2 a = Z[ia], b = Z[ia + 1], c = Z[ia + 2], d = Z[ia + 3];
            const f32x2 a1 = a + c, c1 = a - c, b1 = b + d, d1 = mul_mi(b - d);
            Z[ia] = a1 + b1; Z[ia + 1] = a1 - b1; Z[ia + 2] = c1 + d1; Z[ia + 3] = c1 - d1; }
        __syncthreads(); }
    else if constexpr (H == 1) {
        for (int j = tid; j < N / 2; j += NTHREADS) { const int i2 = zsw(2 * j); const f32x2 a = Z[i2], b = Z[i2 + 1]; Z[i2] = a + b; Z[i2 + 1] = a - b; }
        __syncthreads(); }
}
template <int N> __device__ __forceinline__ void fft_dif(LAS f32x2* Z, int tid) { fft_dif_rec<N, N / 2>(Z, tid); }
template <int N, int E> __device__ __forceinline__ void fft_dit_rec(LAS f32x2* Z, int tid) {
    if constexpr (E <= N / 8) { fft_pass8<N, E, true>(Z, tid); fft_dit_rec<N, E * 8>(Z, tid); }
}
template <int N> __device__ __forceinline__ void fft_dit_inv(LAS f32x2* Z, int tid) {
    constexpr int lg = __builtin_ctz((unsigned)N);
    if constexpr (lg % 3 == 2) {
        for (int j = tid; j < N / 4; j += NTHREADS) { const int ia = zsw(j << 2);
            const f32x2 a = Z[ia], b = Z[ia + 1], c = Z[ia + 2], d = Z[ia + 3];
            const f32x2 a1 = a + b, b1 = a - b, c1 = c + d, d1 = mul_pi(c - d);
            Z[ia] = a1 + c1; Z[ia + 2] = a1 - c1; Z[ia + 1] = b1 + d1; Z[ia + 3] = b1 - d1; }
        __syncthreads(); fft_dit_rec<N, 4>(Z, tid); }
    else if constexpr (lg % 3 == 1) {
        for (int j = tid; j < N / 2; j += NTHREADS) { const int i2 = zsw(2 * j); const f32x2 a = Z[i2], b = Z[i2 + 1]; Z[i2] = a + b; Z[i2 + 1] = a - b; }
        __syncthreads(); fft_dit_rec<N, 2>(Z, tid); }
    else fft_dit_rec<N, 1>(Z, tid);
}
template <int N> __device__ __forceinline__ int brev_n(int k) { int lg = 0; for (int t = N; t > 1; t >>= 1) ++lg; return (int)(__brev((unsigned)k) >> (32 - lg)); }
template <int N, int MODE> __device__ __forceinline__ void spectrum_step(LAS f32x2* Z, f32x2* Hs, int tid, float scale) {
    if (tid == 0) {
        const f32x2 z = Z[0], zh = Z[1];
        if (MODE == 0) { GST(f32x2, Hs) = (f32x2){(z.x + z.y) * scale, 0.f}; GST(f32x2, Hs + N) = (f32x2){(z.x - z.y) * scale, 0.f}; GST(f32x2, Hs + 1) = cconj(zh) * scale; }
        else { const float y0 = (z.x + z.y) * GLD(f32x2, Hs).x, yn = (z.x - z.y) * GLD(f32x2, Hs + N).x; Z[0] = (f32x2){0.5f * (y0 + yn), 0.5f * (y0 - yn)}; Z[1] = cconj(cmul(cconj(zh), GLD(f32x2, Hs + 1))); } }
    if constexpr (MODE == 0) {
#pragma unroll 4
        for (int s = tid == 0 ? NTHREADS : tid; s < N / 2; s += NTHREADS) {
            const int pk = 2 * s, k = brev_n<N>(pk);
            const int pn = brev_n<N>(N - k);
            const int qk = zsw(pk), qn = zsw(pn);
            const f32x2 zk = Z[qk], zn = cconj(Z[qn]), wk = twid((float)k * (0.5f / (float)N));
            const f32x2 E = (zk + zn) * 0.5f, dd = (zk - zn) * 0.5f, O = (f32x2){dd.y, -dd.x};
            const f32x2 wo = cmul(wk, O), Xk = E + wo, Xn = cconj(E - wo);
            GST(f32x2, Hs + pk) = Xk * scale; GST(f32x2, Hs + pn) = Xn * scale;
        }
    } else {
        constexpr int U = 4;
#pragma unroll 1
        for (int s0 = tid; s0 < N / 2; s0 += U * NTHREADS) {
            f32x2 hk[U], hn[U]; int pk[U], pn[U]; bool ok[U];
#pragma unroll
            for (int u = 0; u < U; ++u) { const int s = s0 + u * NTHREADS; ok[u] = s > 0 && s < N / 2; pk[u] = ok[u] ? 2 * s : 2; pn[u] = brev_n<N>(N - brev_n<N>(pk[u]));
                hk[u] = GLD(f32x2, Hs + pk[u]); hn[u] = GLD(f32x2, Hs + pn[u]); }
            __builtin_amdgcn_sched_barrier(0);
#pragma unroll
            for (int u = 0; u < U; ++u) { const int k = brev_n<N>(pk[u]); const int qk = zsw(pk[u]), qn = zsw(pn[u]);
                const f32x2 zk = Z[qk], zn = cconj(Z[qn]), wk = twid((float)k * (0.5f / (float)N));
                const f32x2 E = (zk + zn) * 0.5f, dd = (zk - zn) * 0.5f, O = (f32x2){dd.y, -dd.x};
                const f32x2 wo = cmul(wk, O), Xk = E + wo, Xn = cconj(E - wo);
                const f32x2 Yk = cmul(Xk, hk[u]), Yn = cconj(cmul(Xn, hn[u]));
                const f32x2 Ye = (Yk + Yn) * 0.5f, Yo = cmul((Yk - Yn) * 0.5f, cconj(wk));
                if (ok[u]) { Z[qk] = (f32x2){Ye.x - Yo.y, Ye.y + Yo.x};
                             Z[qn] = (f32x2){Ye.x + Yo.y, -Ye.y + Yo.x}; } }
        }
    }
    __syncthreads();
}
template <int N> __device__ __forceinline__ void hy_conv8(const bf16_t* hrow, int t0, float w0, float w1, float w2, float bias, float (&o)[8]) {
    float x[8]; unpack8(GLD(u32x4, hrow + t0), x);
    const float xm = t0 > 0 ? bf2f(GLD(bf16_t, hrow + t0 - 1)) : 0.f, xp = t0 + 8 < N ? bf2f(GLD(bf16_t, hrow + t0 + 8)) : 0.f;
#pragma unroll
    for (int j = 0; j < 8; ++j) o[j] = w0 * (j ? x[j - 1] : xm) + w1 * x[j] + w2 * (j < 7 ? x[j + 1] : xp) + bias;
}
struct HyRaw { u32x4 x; unsigned short xm, xp; };
template <int N> __device__ __forceinline__ HyRaw hy_load8(const bf16_t* hrow, int t0) {
    HyRaw r; r.x = GLD(u32x4, hrow + t0); r.xm = GLD(bf16_t, hrow + (t0 > 0 ? t0 - 1 : 0)); r.xp = GLD(bf16_t, hrow + (t0 + 8 < N ? t0 + 8 : t0)); return r; }
template <int N> __device__ __forceinline__ void hy_conv8_raw(const HyRaw& r, int t0, float w0, float w1, float w2, float bias, float (&o)[8]) {
    float x[8]; unpack8(r.x, x);
    const float xm = t0 > 0 ? bf2f(r.xm) : 0.f, xp = t0 + 8 < N ? bf2f(r.xp) : 0.f;
#pragma unroll
    for (int j = 0; j < 8; ++j) o[j] = w0 * (j ? x[j - 1] : xm) + w1 * x[j] + w2 * (j < 7 ? x[j + 1] : xp) + bias;
}
template <int N> __device__ __forceinline__ void hyena_channel(const Frame& F, int l, int c, bool is_ctx) {
    LAS f32x2* Z = (LAS f32x2*)F.lds; LAS float* Zf = (LAS float*)F.lds;
    LAS float* red = (LAS float*)(F.lds + (size_t)N * 8);
    const int tid = F.tid;
    unsigned char* scr = F.ws + wsmap::WSCR + (size_t)F.bid * wsmap::WSCR_PER;
    f32x2* Hs0 = (f32x2*)(scr + wsmap::WSCR_H); f32x2* Hs1 = (f32x2*)(scr + wsmap::WSCR_H1); bf16_t* z1 = (bf16_t*)(scr + wsmap::WSCR_Z1);
    float* G1 = (float*)Hs1;
    const float* cw = inp(F, I_HY_CW) + (size_t)l * 3 * HYC; const float* cb = inp(F, I_HY_CB) + (size_t)l * HYC;
    const float* w3 = inp(F, I_HY_W3) + (size_t)l * 64 * 2048;
    const float la = -3.0701134573253946f, lbb = -15.350567286626973f;
    const float delta = fabsf(la + (lbb - la) * ((float)c / 511.0f));
    const bf16_t* hyt = WSP(bf16_t, wsmap::HYT);
    __syncthreads();
    if (tid == 0) { Zf[2 * zsw(N >> 1)] = 0.f; G1[N] = 0.f; }
    float as0 = 0.f, as1 = 0.f;
    { const bf16_t* hidp = WSP(bf16_t, wsmap::HID) + ((size_t)l * LSEQ + (is_ctx ? SEQ : 0)) * 64;
      const int lane = F.lane, col = lane & 15, kg = lane >> 4; const float dscale = delta / (float)(N > 1 ? N - 1 : 1);
      bf16x8 bfr[2];
#pragma unroll
      for (int kk = 0; kk < 2; ++kk)
#pragma unroll
          for (int j = 0; j < 8; ++j) bfr[kk][j] = (short)f2bf1(w3[(size_t)(kk * 32 + kg * 8 + j) * 2048 + (col & 3) * 512 + c]);
      constexpr int US = 8;
      const int q = col >> 2, tp = col & 3; const bool bwd = tp & 1;
#pragma unroll 1
      for (int db = F.wave * 16; db < N; db += 128 * US) {
          bf16x8 a0[US], a1[US];
#pragma unroll
          for (int u = 0; u < US; ++u) { const int d0 = db + u * 128; const bf16_t* ap = hidp + (size_t)((d0 < N ? d0 : db) + col) * 64 + kg * 8;
              a0[u] = GLD(bf16x8, ap); a1[u] = GLD(bf16x8, ap + 32); }
          __builtin_amdgcn_sched_barrier(0);
#pragma unroll
          for (int u = 0; u < US; ++u) { const int d0 = db + u * 128;
              f32x4 a = (f32x4){0.f, 0.f, 0.f, 0.f};
              a = __builtin_amdgcn_mfma_f32_16x16x32_bf16(a0[u], bfr[0], a, 0, 0, 0);
              a = __builtin_amdgcn_mfma_f32_16x16x32_bf16(a1[u], bfr[1], a, 0, 0, 0);
              const int d = d0 + kg * 4 + q;
              const float aq = q == 0 ? a[0] : q == 1 ? a[1] : q == 2 ? a[2] : a[3];
              const float v = aq * __expf(-(float)d * dscale);
              const int j = bwd ? 2 * N - d : d;
              if (d0 < N && (!bwd || d > 0)) { if (tp < 2) { Zf[2 * zsw(j >> 1) + (j & 1)] = v; as0 += fabsf(v); } else { GST(float, G1 + j) = v; as1 += fabsf(v); } } } } }
    as0 = wave_sum(as0); as1 = wave_sum(as1);
    if (F.lane == 0) { red[F.wave] = as0; red[8 + F.wave] = as1; }
    __syncthreads();
    float inv0 = 0.f, inv1 = 0.f;
#pragma unroll
    for (int q = 0; q < 8; ++q) { inv0 += red[q]; inv1 += red[8 + q]; }
    inv0 = 1.0f / (inv0 + 1e-6f); inv1 = 1.0f / (inv1 + 1e-6f);
    fft_dif<N>(Z, tid);
    spectrum_step<N, 0>(Z, Hs0, tid, inv0);
#pragma unroll 4
    for (int j = tid * 4; j < 2 * N; j += NTHREADS * 4) *(LAS f32x4*)(Zf + 2 * zsw(j >> 1)) = GLD(f32x4, G1 + j);
    __syncthreads();
    fft_dif<N>(Z, tid);
    spectrum_step<N, 0>(Z, Hs1, tid, inv1);
    const float vw0 = cw[c], vw1 = cw[HYC + c], vw2 = cw[2 * HYC + c], vb = cb[c];
#pragma unroll 1
    for (int o = 0; o < 2; ++o) {
        const int xp = o + 1;
        f32x2* Hs = o ? Hs1 : Hs0;
        const float skip = inp(F, I_HY_SKIP)[((size_t)l * 2 + o) * 512 + c];
        const float xw0 = cw[xp * 512 + c], xw1 = cw[HYC + xp * 512 + c], xw2 = cw[2 * HYC + xp * 512 + c], xb = cb[xp * 512 + c];
#pragma unroll 1
        for (int b = 0; b < NB; ++b) {
            const int r0 = is_ctx ? NLAT + b * CTXL : b * SEQ;
            const bf16_t* vrow = hyt + (size_t)c * MROWS + r0; const bf16_t* xrow = hyt + (size_t)(xp * 512 + c) * MROWS + r0;
            bf16_t* z1b = z1 + (size_t)b * N;
            constexpr int UI = 4;
#pragma unroll 1
            for (int tb = tid * 8; tb < N; tb += UI * NTHREADS * 8) {
                HyRaw rv[UI]; u32x4 rz[UI];
#pragma unroll
                for (int i = 0; i < UI; ++i) { const int t0 = tb + i * NTHREADS * 8; const int tc = t0 < N ? t0 : tb;
                    if (o == 0) rv[i] = hy_load8<N>(vrow, tc); else rz[i] = GLD(u32x4, z1b + tc); }
                __builtin_amdgcn_sched_barrier(0);
#pragma unroll
                for (int i = 0; i < UI; ++i) { const int t0 = tb + i * NTHREADS * 8; float u[8];
                    if (t0 < N) { if (o == 0) hy_conv8_raw<N>(rv[i], t0, vw0, vw1, vw2, vb, u); else unpack8(rz[i], u);
                        LAS float* zp = Zf + 2 * zsw(t0 >> 1);
                        *(LAS f32x4*)(zp) = (f32x4){u[0], u[1], u[2], u[3]}; *(LAS f32x4*)(zp + 4) = (f32x4){u[4], u[5], u[6], u[7]}; } } }
#pragma unroll 4
            for (int t0 = N + tid * 8; t0 < 2 * N; t0 += NTHREADS * 8) { LAS float* zp = Zf + 2 * zsw(t0 >> 1);
                *(LAS f32x4*)(zp) = (f32x4){0.f, 0.f, 0.f, 0.f}; *(LAS f32x4*)(zp + 4) = (f32x4){0.f, 0.f, 0.f, 0.f}; }
            __syncthreads();
#ifdef PROBE_FFT
            fft_dif<N>(Z, tid); fft_dit_inv<N>(Z, tid);
            for (int j = tid; j < N; j += NTHREADS) Z[j] = Z[j] * (1.0f / (float)N);
            __syncthreads();
#endif
            fft_dif<N>(Z, tid);
            spectrum_step<N, 1>(Z, Hs, tid, 1.0f);
            fft_dit_inv<N>(Z, tid);
            const float sn = 1.0f / (float)N;
#pragma unroll 1
            for (int tb = tid * 8; tb < N; tb += UI * NTHREADS * 8) {
                HyRaw rv[UI], rx[UI]; u32x4 rz[UI];
#pragma unroll
                for (int i = 0; i < UI; ++i) { const int t0 = tb + i * NTHREADS * 8; const int tc = t0 < N ? t0 : tb;
                    if (o == 0) rv[i] = hy_load8<N>(vrow, tc); else rz[i] = GLD(u32x4, z1b + tc);
                    rx[i] = hy_load8<N>(xrow, tc); }
                __builtin_amdgcn_sched_barrier(0);
#pragma unroll
                for (int i = 0; i < UI; ++i) { const int t0 = tb + i * NTHREADS * 8; float u[8], xv[8], zo[8];
                    if (t0 < N) {
                        if (o == 0) hy_conv8_raw<N>(rv[i], t0, vw0, vw1, vw2, vb, u); else unpack8(rz[i], u);
                        hy_conv8_raw<N>(rx[i], t0, xw0, xw1, xw2, xb, xv);
                        const LAS float* zp = Zf + 2 * zsw(t0 >> 1);
                        const f32x4 y0 = *(const LAS f32x4*)(zp), y1 = *(const LAS f32x4*)(zp + 4);
#pragma unroll
                        for (int j = 0; j < 8; ++j) zo[j] = xv[j] * ((j < 4 ? y0[j] : y1[j - 4]) * sn + u[j] * skip);
                        u32x4 w; w.x = cvt_pk_bf16(zo[0], zo[1]); w.y = cvt_pk_bf16(zo[2], zo[3]); w.z = cvt_pk_bf16(zo[4], zo[5]); w.w = cvt_pk_bf16(zo[6], zo[7]);
                        if (o == 0) GST(u32x4, z1b + t0) = w; else GST(u32x4, WSP(bf16_t, wsmap::YBT) + (size_t)c * MROWS + r0 + t0) = w; } } }
            __syncthreads();
        }
    }
}
constexpr int HYTR_ITEMS = (512 / 64) * (MROWS / 64);
__device__ __forceinline__ void hyena_transpose_item(const Frame& F, int it) {
    LAS bf16_t* tile = (LAS bf16_t*)F.lds;
    const int cb = it % 8, rb = it / 8, tid = F.tid;
    __syncthreads();
    { const int ch = tid >> 3, r8 = (tid & 7) * 8; const u32x4 v = *(const u32x4*)(WSP(bf16_t, wsmap::YBT) + (size_t)(cb * 64 + ch) * MROWS + rb * 64 + r8);
      const unsigned vw[4] = {v.x, v.y, v.z, v.w};
#pragma unroll
      for (int j = 0; j < 8; ++j) tile[ch * 66 + r8 + j] = (bf16_t)((vw[j >> 1] >> ((j & 1) * 16)) & 0xFFFFu); }
    __syncthreads();
    { const int r = tid >> 3, c8 = (tid & 7) * 8; unsigned w[4];
#pragma unroll
      for (int j = 0; j < 4; ++j) w[j] = (unsigned)tile[(c8 + 2 * j) * 66 + r] | ((unsigned)tile[(c8 + 2 * j + 1) * 66 + r] << 16);
      GST(u32x4, WSP(bf16_t, wsmap::HYB) + (size_t)(rb * 64 + r) * HY_LD + 1024 + 512 + cb * 64 + c8) = (u32x4){w[0], w[1], w[2], w[3]}; }
}

__device__ __forceinline__ Frame phase_frame(const Frame& F) {
    Frame R = F; R.tid = F.wave * 64 + lane_id();
#ifndef CPU_EMU
    asm volatile("" : "+v"(R.tid)); asm volatile("" : "+s"(R.bid)); asm volatile("" : "+s"(R.G)); asm volatile("" : "+s"(R.ws));
#endif
    R.ws = (unsigned char*)(GAS unsigned char*)R.ws;
    R.lane = R.tid & 63; R.wave = __builtin_amdgcn_readfirstlane(R.tid >> 6); return R;
}
__device__ __forceinline__ int opaque_s(int v) {
#ifndef CPU_EMU
    asm volatile("" : "+s"(v));
#endif
    return v;
}
constexpr int PH_PER_LAYER = 12, NPHASES = 1 + DEPTH * PH_PER_LAYER + 1;
template <int SEL = 15, int QOFF = 0> __device__ __forceinline__ void phase_mix1(const Frame& F, int l) {
    const int n_hy = (l < DEPTH - 1) ? 1024 : 512, n_hg = 8 * NSC, n_ml = 8 * NSC, n_sd = 16 * NSC, qb = l * 8 + QOFF;
    if constexpr (SEL & 1) { int nx = 0; q_issue(F, qb + 0, nx); for (;;) { const Frame Fh = phase_frame(F); const int it = q_take(Fh, nx); if (it >= n_hy) break; q_issue(Fh, qb + 0, nx); if (it < 512) hyena_channel<SEQ>(Fh, l, it, false); else { hyena_channel<CTXL>(Fh, l, it - 512, true);
#ifdef PROBE_CTX2
        hyena_channel<CTXL>(Fh, l, it - 512, true);
#endif
    } } }
    if constexpr (SEL & 2) { int nx = 0; q_issue(F, qb + 1, nx); for (;;) { const Frame Fh = phase_frame(F); const int it = q_take(Fh, nx); if (it >= n_hg) break; q_issue(Fh, qb + 1, nx); hg_m1f_item(Fh, l, it); } }
    if constexpr (SEL & 4) { int nx = 0; q_issue(F, qb + 2, nx); for (;;) { const Frame Fh = phase_frame(F); const int it = q_take(Fh, nx); if (it >= n_ml) break; q_issue(Fh, qb + 2, nx); ml_m1f_item(Fh, l, it); } }
    if constexpr (SEL & 8) for (;;) { const Frame Fh = phase_frame(F); const int it = q_pull(Fh, qb + 3); if (it >= n_sd) break; sd_m1f_item(Fh, l, it); }
}
__device__ __forceinline__ void phase_mix2(const Frame& F, int l) {
    const int n_c = M2_SSD + M2_ML + M2_HG;
    for (int it = F.bid; it < n_c + HYTR_ITEMS; it += F.G) { if (it < n_c) carry_item(F, it); else hyena_transpose_item(F, it - n_c); }
}
template <int SEL = 15, int QOFF = 0> __device__ __forceinline__ void phase_mix3(const Frame& F, int l) {
    const int c0 = (l < DEPTH - 1) ? 0 : NSC_C, nc = NSC - c0;
    const int n_hg = 8 * nc, n_ml = 8 * nc, n_sd = 16 * nc, qb = l * 8 + 4 + QOFF;
    if constexpr (SEL & 2) { int nx = 0; q_issue(F, qb + 0, nx); for (;;) { const Frame Fh = phase_frame(F); const int it = q_take(Fh, nx); if (it >= n_hg) break; q_issue(Fh, qb + 0, nx); hg_m3_item(Fh, l, (it / nc) * NSC + c0 + it % nc); } }
    if constexpr (SEL & 4) { int nx = 0; q_issue(F, qb + 1, nx); for (;;) { const Frame Fh = phase_frame(F); const int it = q_take(Fh, nx); if (it >= n_ml) break; q_issue(Fh, qb + 1, nx); ml_m3_item(Fh, l, (it / nc) * NSC + c0 + it % nc); } }
    if constexpr (SEL & 8) for (;;) { const Frame Fh = phase_frame(F); const int it = q_pull(Fh, qb + 2); if (it >= n_sd) break; sd_m3_item(Fh, l, (it / nc) * NSC + c0 + it % nc); }
}
__device__ __forceinline__ void phase_k0(const Frame& F, int l) {
    phase_norm1(F, l);
}

#ifdef CPU_EMU
#define DYN_LDS_DECL unsigned char* shm = emu::dyn_lds();
#else
#define DYN_LDS_DECL extern __shared__ __attribute__((aligned(16))) unsigned char shm[];
#endif

#ifdef CPU_EMU
#define MEGA_TARGET
#else
#define MEGA_TARGET __attribute__((target("no-packed-fp32-ops")))
#endif
__global__ void __launch_bounds__(512, 2) MEGA_TARGET mega(Params p) {
    DYN_LDS_DECL
    Frame F; F.lds = (LAS unsigned char*)shm; F.tid = threadIdx.x; F.lane = F.tid & 63; F.wave = __builtin_amdgcn_readfirstlane(F.tid >> 6);
    F.G = gridDim.x; F.bid = blockIdx.x; F.ws = p.ws; F.p = &p;
    if (F.tid < 38) *(LAS unsigned long long*)(F.lds + PTR_OFF + F.tid * 8) = (unsigned long long)p.in[F.tid];
    __syncthreads();
    volatile LAS unsigned* xbw = (volatile LAS unsigned*)(F.lds + LDS_BYTES - 16);
    const int lo = p.ph_lo, hi = p.ph_hi;
    XcdBarrier bar; bar.bar = (unsigned*)(F.ws + wsmap::CTL); bar.x = 0; bar.st = xbw;
    if (hi - lo > 1) { if (F.tid == 0) { xbw[0] = 0u; xbw[1] = 0u; } __syncthreads(); bar = xcd_barrier_post((unsigned*)(F.ws + wsmap::CTL), xbw, F.tid == 0); }
#ifndef REPEAT_PH
#define REPEAT_PH 0
#endif
#ifndef REPEAT_SEL
#define REPEAT_SEL 15
#endif
#define RP(b, call) do { call; if constexpr ((REPEAT_PH >> (b)) & 1) { __syncthreads(); call; } } while (0)
#define IN(k) (lo <= (k) && (k) < hi)
#define SEAM(k) do { if (IN(k) && IN((k) + 1)) xcd_barrier(bar, F.wave == 0 && lane_id() == 0); } while (0)
    if (IN(0)) RP(0, phase_a0(phase_frame(F)));
    SEAM(0);
#pragma unroll 1
    for (int l0 = 0; l0 < DEPTH; ++l0) { const int pb = 1 + l0 * PH_PER_LAYER;
        if (IN(pb + 0)) phase_k0(phase_frame(F), opaque_s(l0));
        SEAM(pb + 0);
        if (IN(pb + 1)) RP(2, phase_proj(phase_frame(F)));
        SEAM(pb + 1);
        if (IN(pb + 2)) { phase_mix1(phase_frame(F), opaque_s(l0)); if constexpr ((REPEAT_PH >> 3) & 1) { __syncthreads(); phase_mix1<REPEAT_SEL, 16>(phase_frame(F), opaque_s(l0)); } }
        SEAM(pb + 2);
        if (IN(pb + 3)) phase_mix2(phase_frame(F), opaque_s(l0));
        SEAM(pb + 3);
        if (IN(pb + 4)) { phase_mix3(phase_frame(F), opaque_s(l0)); if constexpr ((REPEAT_PH >> 5) & 1) { __syncthreads(); phase_mix3<REPEAT_SEL, 16>(phase_frame(F), opaque_s(l0)); } }
        SEAM(pb + 4);
        if (IN(pb + 5)) RP(6, phase_gate_branch(phase_frame(F), opaque_s(l0)));
        SEAM(pb + 5);
        if (IN(pb + 6)) phase_outproj(phase_frame(F), opaque_s(l0));
        SEAM(pb + 6);
        if (IN(pb + 7)) RP(8, phase_norm2_router(phase_frame(F), opaque_s(l0)));
        SEAM(pb + 7);
        if (IN(pb + 8)) RP(9, phase_topk(phase_frame(F), opaque_s(l0)));
        SEAM(pb + 8);
        if (IN(pb + 9)) RP(10, phase_gather(phase_frame(F), opaque_s(l0)));
        SEAM(pb + 9);
        if (IN(pb + 10)) RP(11, phase_moe_up(phase_frame(F), opaque_s(l0)));
        SEAM(pb + 10);
        if (IN(pb + 11)) RP(12, phase_moe_down(phase_frame(F), opaque_s(l0)));
        SEAM(pb + 11);
    }
    if (IN(NPHASES - 1)) phase_final(phase_frame(F));
#undef IN
#undef SEAM
}

#ifndef CPU_EMU
extern "C" void kernel_launch(void* const* d_in, const int* in_sizes, int n_in, void* d_out, int out_size, void* d_ws, size_t ws_size, hipStream_t stream) {
    static int grid = 0;
    if (grid == 0) {
        if (n_in != 38 || out_size != NLAT * D || ws_size < wsmap::END) { fprintf(stderr, "kernel_launch: unexpected shapes (n_in %d, out %d, ws %zu < %zu)\n", n_in, out_size, ws_size, (size_t)wsmap::END); grid = -1; return; }
        if (hipFuncSetAttribute((const void*)mega, hipFuncAttributeMaxDynamicSharedMemorySize, LDS_BYTES) != hipSuccess) { fprintf(stderr, "kernel_launch: hipFuncSetAttribute failed\n"); grid = -1; return; }
        int dev = 0, cus = 0; hipGetDevice(&dev); hipDeviceGetAttribute(&cus, hipDeviceAttributeMultiprocessorCount, dev);
        grid = cus > 0 ? cus : 256;
    }
    if (grid < 0) return;
    hipMemsetAsync((char*)d_ws + wsmap::CTL, 0, wsmap::CTL_BYTES, stream);
    Params p{};
    for (int i = 0; i < 38; ++i) p.in[i] = (const float*)d_in[i];
    p.out = (float*)d_out; p.ws = (unsigned char*)d_ws;
#if MK_PER_PHASE
    for (int ph = 0; ph < NPHASES; ++ph) { p.ph_lo = ph; p.ph_hi = ph + 1; hipLaunchKernelGGL(mega, dim3(grid), dim3(NTHREADS), LDS_BYTES, stream, p); }
#else
    p.ph_lo = 0; p.ph_hi = NPHASES; hipLaunchKernelGGL(mega, dim3(grid), dim3(NTHREADS), LDS_BYTES, stream, p);
#endif
}
#endif
```
